# Optimizing an MI355X kernel written in HIP

```python
import math
import jax, jax.numpy as jnp
from jax import lax
import numpy as np

D_MODEL = 1024
BATCH = 2
SEQ = 8192
DEPTH = 4
DEC_BATCH = 128
DEC_SEQ = 4
PAST_LEN = 8192
PAGE_SIZE = 128

N_A_LAYERS = DEPTH // 2
N_B_LAYERS = DEPTH - N_A_LAYERS
GROUP_SIZE = 16
N_GROUPS = D_MODEL // GROUP_SIZE
STATE_DIM = 64
DT_MIN = 0.001
DT_MAX = 0.1
HEAD_DIM = 64
N_HEADS = D_MODEL // HEAD_DIM
N_KV_HEADS = max(1, N_HEADS // 8)
Q_PER_KV = N_HEADS // N_KV_HEADS
WINDOW = 128
BLOCK = WINDOW
ATTN_SCALE = 1.0 / math.sqrt(HEAD_DIM)
NUM_BUCKETS = 32
MAX_DISTANCE = WINDOW
D_FF = ((8 * D_MODEL // 3 + 127) // 128) * 128
N_NORMS = 6
RMS_EPS = 1e-6

kernel_name = 'yoco_s5_swa_sink_macaron'


def _rms(x, g):
    xf = x.astype(jnp.float32)
    y = xf * lax.rsqrt(jnp.mean(xf * xf, axis=-1, keepdims=True) + RMS_EPS) * g.astype(jnp.float32)
    return y.astype(x.dtype)


def _swiglu(x, w_gu, w_down):
    gate, up = jnp.split(x @ w_gu, 2, axis=-1)
    return (jax.nn.silu(gate) * up) @ w_down


def _ssm_combine(left, right):
    a_l, b_l = left
    a_r, b_r = right
    return a_r * a_l, a_r * b_l + b_r


def _ssm_mixer(u, lam_re, lam_im, log_dt, b_re, b_im, c_re, c_im, d, w_glu, b_glu, x0_re, x0_im):
    f32 = jnp.float32
    bsz, seq, _ = u.shape
    uf = u.astype(f32)
    ug = uf.reshape(bsz, seq, N_GROUPS, GROUP_SIZE)
    lam = lax.complex(lam_re.astype(f32), lam_im.astype(f32))
    dt = jnp.exp(log_dt.astype(f32))
    lam_dt = lam * dt
    lam_bar = jnp.exp(lam_dt)
    b_bar = ((lam_bar - 1.0) / lam)[..., None] * lax.complex(b_re.astype(f32), b_im.astype(f32))
    bu = lax.complex(jnp.einsum('bsgh,gph->bsgp', ug, jnp.real(b_bar)),
                     jnp.einsum('bsgh,gph->bsgp', ug, jnp.imag(b_bar)))
    a = jnp.broadcast_to(lam_bar, bu.shape)
    xs = lax.associative_scan(_ssm_combine, (a, bu), axis=1)[1]
    if x0_re is not None:
        t = jnp.arange(1, seq + 1, dtype=f32)[:, None, None]
        x0 = lax.complex(x0_re.astype(f32), x0_im.astype(f32))
        xs = xs + jnp.exp(lam_dt * t) * x0[:, None]
    y = (jnp.einsum('bsgp,ghp->bsgh', jnp.real(xs), c_re.astype(f32))
         - jnp.einsum('bsgp,ghp->bsgh', jnp.imag(xs), c_im.astype(f32)))
    y = y.reshape(bsz, seq, D_MODEL) + d.astype(f32) * uf
    h = jax.nn.gelu(y) @ w_glu.astype(f32) + b_glu.astype(f32)
    out = h[..., :D_MODEL] * jax.nn.sigmoid(h[..., D_MODEL:])
    last = xs[:, -1]
    return out.astype(u.dtype), jnp.real(last), jnp.imag(last)


def _t5_bucket(dist):
    n = jnp.maximum(dist, 0)
    max_exact = NUM_BUCKETS // 2
    nf = jnp.maximum(n, 1).astype(jnp.float32)
    large = max_exact + (jnp.log(nf / max_exact) / math.log(MAX_DISTANCE / max_exact)
                         * (NUM_BUCKETS - max_exact)).astype(jnp.int32)
    large = jnp.minimum(large, NUM_BUCKETS - 1)
    return jnp.where(n < max_exact, n, large)


def _band_bias_mask(rel_bias, n_q, n_k, q_offset):
    dist = (jnp.arange(n_q)[:, None] + q_offset) - jnp.arange(n_k)[None, :]
    valid = (dist >= 0) & (dist < WINDOW)
    bias = rel_bias.astype(jnp.float32)[_t5_bucket(dist)]
    bias = bias.transpose(2, 0, 1).reshape(N_KV_HEADS, Q_PER_KV, n_q, n_k)
    return bias, valid


def _prompt_bands(k, v, rel_bias):
    bsz, seq = k.shape[:2]
    nb = seq // BLOCK

    def band(t):
        tb = t.reshape(bsz, nb, BLOCK, N_KV_HEADS, HEAD_DIM)
        prev = jnp.concatenate([jnp.zeros_like(tb[:, :1]), tb[:, :-1]], axis=1)
        return jnp.concatenate([prev, tb], axis=2)

    bias, valid = _band_bias_mask(rel_bias, BLOCK, 2 * BLOCK, BLOCK)
    key_ok = (jnp.arange(nb)[:, None] > 0) | (jnp.arange(2 * BLOCK)[None, :] >= BLOCK)
    return band(k), band(v), bias, valid[None] & key_ok[:, None, :]


def _window_attention(u, k_cat, v_cat, bias, mask, w_q, b_q, sinks, w_o, b_o):
    f32 = jnp.float32
    bsz, seq, _ = u.shape
    n_blk = k_cat.shape[1]
    q = (u @ w_q + b_q).reshape(bsz, n_blk, seq // n_blk, N_KV_HEADS, Q_PER_KV, HEAD_DIM)
    s = jnp.einsum('bnqkgd,bnjkd->bnkgqj', q, k_cat, preferred_element_type=f32) * ATTN_SCALE + bias
    s = jnp.where(mask[None, :, None, None], s, -jnp.inf)
    sink = sinks.astype(f32).reshape(N_KV_HEADS, Q_PER_KV)[None, None, :, :, None, None]
    mx = jnp.maximum(s.max(axis=-1, keepdims=True), sink)
    p = jnp.exp(s - mx)
    p = p / (p.sum(axis=-1, keepdims=True) + jnp.exp(sink - mx))
    o = jnp.einsum('bnkgqj,bnjkd->bnqkgd', p.astype(v_cat.dtype), v_cat, preferred_element_type=f32)
    return o.reshape(bsz, seq, N_HEADS * HEAD_DIM).astype(u.dtype) @ w_o + b_o


def _trunk(x, ssm_re0, ssm_im0, win_k0, win_v0, w):
    bsz, seq, _ = x.shape
    new_re, new_im = [], []
    for l in range(DEPTH):
        if l == N_A_LAYERS:
            kv = (_rms(x, w['kv_norm_g']) @ w['w_kv'] + w['b_kv']).reshape(bsz, seq, 2, N_KV_HEADS, HEAD_DIM)
            k, v = kv[:, :, 0], kv[:, :, 1]
            if win_k0 is None:
                k_cat, v_cat, bias, mask = _prompt_bands(k, v, w['rel_bias'])
                new_k, new_v = k[:, -WINDOW:], v[:, -WINDOW:]
            else:
                n_past = win_k0.shape[1]
                k_full = jnp.concatenate([win_k0.astype(k.dtype), k], axis=1)
                v_full = jnp.concatenate([win_v0.astype(v.dtype), v], axis=1)
                bias, valid = _band_bias_mask(w['rel_bias'], seq, n_past + seq, n_past)
                k_cat, v_cat, mask = k_full[:, None], v_full[:, None], valid[None]
                new_k, new_v = k_full[:, -WINDOW:], v_full[:, -WINDOW:]
        g = w['norm_g'][l]
        x = x + 0.5 * _rms(_swiglu(_rms(x, g[0]), w['ffn1_w_gu'][l], w['ffn1_w_down'][l]), g[1])
        u = _rms(x, g[2])
        if l < N_A_LAYERS:
            m, fr, fi = _ssm_mixer(
                u, w['ssm_lambda_re'][l], w['ssm_lambda_im'][l], w['ssm_log_dt'][l],
                w['ssm_b_re'][l], w['ssm_b_im'][l], w['ssm_c_re'][l], w['ssm_c_im'][l],
                w['ssm_d'][l], w['ssm_w_glu'][l], w['ssm_b_glu'][l],
                None if ssm_re0 is None else ssm_re0[l],
                None if ssm_im0 is None else ssm_im0[l])
            new_re.append(fr)
            new_im.append(fi)
        else:
            bl = l - N_A_LAYERS
            m = _window_attention(u, k_cat, v_cat, bias, mask, w['attn_w_q'][bl], w['attn_b_q'][bl],
                                  w['attn_sinks'][bl], w['attn_w_o'][bl], w['attn_b_o'][bl])
        x = x + _rms(m, g[3])
        x = x + 0.5 * _rms(_swiglu(_rms(x, g[4]), w['ffn2_w_gu'][l], w['ffn2_w_down'][l]), g[5])
    return x, jnp.stack(new_re), jnp.stack(new_im), new_k, new_v


def setup_inputs(seed: int = 0) -> dict:
    key = jax.random.key(seed)
    kit = iter(list(jax.random.split(key, 64)))
    f32 = jnp.float32

    def nrm(shape, scale):
        return jax.random.normal(next(kit), shape, f32) * scale

    win_rows = min(WINDOW, PAST_LEN)
    kvw = 2 * N_KV_HEADS * HEAD_DIM
    qw = N_HEADS * HEAD_DIM
    return {
        'x_prompt': nrm((BATCH, SEQ, D_MODEL), 1.0),
        'x_sample': nrm((DEC_BATCH, DEC_SEQ, D_MODEL), 1.0),
        'state_ssm_re': nrm((N_A_LAYERS, DEC_BATCH, N_GROUPS, STATE_DIM), 0.5),
        'state_ssm_im': nrm((N_A_LAYERS, DEC_BATCH, N_GROUPS, STATE_DIM), 0.5),
        'cache_win_k': nrm((DEC_BATCH, win_rows, N_KV_HEADS, HEAD_DIM), 1.0),
        'cache_win_v': nrm((DEC_BATCH, win_rows, N_KV_HEADS, HEAD_DIM), 1.0),
        'norm_g': 1.0 + nrm((DEPTH, N_NORMS, D_MODEL), 0.05),
        'ffn1_w_gu': nrm((DEPTH, D_MODEL, 2 * D_FF), D_MODEL ** -0.5),
        'ffn1_w_down': nrm((DEPTH, D_FF, D_MODEL), D_FF ** -0.5),
        'ffn2_w_gu': nrm((DEPTH, D_MODEL, 2 * D_FF), D_MODEL ** -0.5),
        'ffn2_w_down': nrm((DEPTH, D_FF, D_MODEL), D_FF ** -0.5),
        'ssm_lambda_re': -0.5 + nrm((N_A_LAYERS, N_GROUPS, STATE_DIM), 0.01),
        'ssm_lambda_im': jnp.pi * jnp.arange(STATE_DIM, dtype=f32) + nrm((N_A_LAYERS, N_GROUPS, STATE_DIM), 0.01),
        'ssm_log_dt': jax.random.uniform(next(kit), (N_A_LAYERS, N_GROUPS, STATE_DIM), f32,
                                         math.log(DT_MIN), math.log(DT_MAX)),
        'ssm_b_re': nrm((N_A_LAYERS, N_GROUPS, STATE_DIM, GROUP_SIZE), (2 * GROUP_SIZE) ** -0.5),
        'ssm_b_im': nrm((N_A_LAYERS, N_GROUPS, STATE_DIM, GROUP_SIZE), (2 * GROUP_SIZE) ** -0.5),
        'ssm_c_re': nrm((N_A_LAYERS, N_GROUPS, GROUP_SIZE, STATE_DIM), STATE_DIM ** -0.5),
        'ssm_c_im': nrm((N_A_LAYERS, N_GROUPS, GROUP_SIZE, STATE_DIM), STATE_DIM ** -0.5),
        'ssm_d': nrm((N_A_LAYERS, D_MODEL), 1.0),
        'ssm_w_glu': nrm((N_A_LAYERS, D_MODEL, 2 * D_MODEL), D_MODEL ** -0.5),
        'ssm_b_glu': nrm((N_A_LAYERS, 2 * D_MODEL), 0.01),
        'kv_norm_g': 1.0 + nrm((D_MODEL,), 0.05),
        'w_kv': nrm((D_MODEL, kvw), D_MODEL ** -0.5),
        'b_kv': nrm((kvw,), 0.01),
        'attn_w_q': nrm((N_B_LAYERS, D_MODEL, qw), D_MODEL ** -0.5),
        'attn_b_q': nrm((N_B_LAYERS, qw), 0.01),
        'attn_sinks': nrm((N_B_LAYERS, N_HEADS), 0.5),
        'attn_w_o': nrm((N_B_LAYERS, qw, D_MODEL), qw ** -0.5),
        'attn_b_o': nrm((N_B_LAYERS, D_MODEL), 0.01),
        'rel_bias': nrm((NUM_BUCKETS, N_HEADS), 0.5),
    }


def reference(x_prompt, x_sample, state_ssm_re, state_ssm_im, cache_win_k, cache_win_v,
              norm_g, ffn1_w_gu, ffn1_w_down, ffn2_w_gu, ffn2_w_down,
              ssm_lambda_re, ssm_lambda_im, ssm_log_dt, ssm_b_re, ssm_b_im, ssm_c_re, ssm_c_im,
              ssm_d, ssm_w_glu, ssm_b_glu,
              kv_norm_g, w_kv, b_kv,
              attn_w_q, attn_b_q, attn_sinks, attn_w_o, attn_b_o, rel_bias):
    w = dict(norm_g=norm_g, ffn1_w_gu=ffn1_w_gu, ffn1_w_down=ffn1_w_down,
             ffn2_w_gu=ffn2_w_gu, ffn2_w_down=ffn2_w_down,
             ssm_lambda_re=ssm_lambda_re, ssm_lambda_im=ssm_lambda_im, ssm_log_dt=ssm_log_dt,
             ssm_b_re=ssm_b_re, ssm_b_im=ssm_b_im, ssm_c_re=ssm_c_re, ssm_c_im=ssm_c_im,
             ssm_d=ssm_d, ssm_w_glu=ssm_w_glu, ssm_b_glu=ssm_b_glu,
             kv_norm_g=kv_norm_g, w_kv=w_kv, b_kv=b_kv,
             attn_w_q=attn_w_q, attn_b_q=attn_b_q, attn_sinks=attn_sinks,
             attn_w_o=attn_w_o, attn_b_o=attn_b_o, rel_bias=rel_bias)
    y_prompt, re_p, im_p, k_p, v_p = _trunk(x_prompt, None, None, None, None, w)
    y_sample, re_s, im_s, k_s, v_s = _trunk(x_sample, state_ssm_re, state_ssm_im, cache_win_k, cache_win_v, w)
    return (y_prompt, y_sample, re_p, im_p, k_p, v_p, re_s, im_s, k_s, v_s)
```

```cpp
#include <hip/hip_runtime.h>
#include <hip/hip_cooperative_groups.h>
#include <cstdio>
namespace cg = cooperative_groups;

#ifndef MK_MULTI
#define MK_MULTI 0
#endif

#ifndef REP_PRO
#define REP_PRO 1
#define REP_GU 1
#define REP_DN 1
#define REP_MX 1
#define REP_FX 1
#endif
#define REPLOOP(n) for (int rep = 0, tid = tid0; rep < (n); ++rep, ({ asm volatile("" : "+v"(tid)); }))
#define LAS __attribute__((address_space(3)))
typedef unsigned short bf16_t;
typedef short bf16x8 __attribute__((ext_vector_type(8)));
typedef short bf16x4 __attribute__((ext_vector_type(4)));
typedef float f32x4 __attribute__((ext_vector_type(4)));
typedef float f32x2 __attribute__((ext_vector_type(2)));
typedef unsigned u32x4 __attribute__((ext_vector_type(4)));
typedef unsigned u32x2 __attribute__((ext_vector_type(2)));

constexpr int D = 1024, FF = 2816, TP = 16384, TS = 512, T = TP + TS, SEQ = 8192;
constexpr int NG = 64, NP = 64, GS = 16;
constexpr int WIN = 128;
constexpr float RMS_EPS = 1e-6f;
constexpr int NTHREADS = 512, NWAVES = 8;
constexpr int LDS_BYTES = 131072 + 16;
constexpr int NPHASES = 41;

constexpr size_t O_Y = 0;
constexpr size_t O_REP = (size_t)T * D;
constexpr size_t O_IMP = O_REP + 16384;
constexpr size_t O_KP = O_IMP + 16384;
constexpr size_t O_VP = O_KP + 32768;
constexpr size_t O_RES = O_VP + 32768;
constexpr size_t O_IMS = O_RES + 1048576;
constexpr size_t O_KS = O_IMS + 1048576;
constexpr size_t O_VS = O_KS + 2097152;
constexpr size_t O_END = O_VS + 2097152;

constexpr size_t W_GU = 0;
constexpr size_t W_DN = W_GU + (size_t)8 * 5632 * 1024 * 2;
constexpr size_t W_GLU = W_DN + (size_t)8 * 1024 * 2816 * 2;
constexpr size_t W_Q = W_GLU + (size_t)2 * 2048 * 1024 * 2;
constexpr size_t W_O = W_Q + (size_t)2 * 1024 * 1024 * 2;
constexpr size_t W_KV = W_O + (size_t)2 * 1024 * 1024 * 2;
constexpr size_t W_XB = W_KV + (size_t)256 * 1024 * 2;
constexpr size_t W_H = W_XB + (size_t)T * D * 2;
constexpr size_t W_QB = W_H;
constexpr size_t W_OB = W_H + (size_t)T * D * 2;
constexpr size_t W_F = W_H + (size_t)T * FF * 2;
constexpr size_t W_KVB = W_F + (size_t)T * D * 2;
constexpr size_t W_SFIN = W_KVB + (size_t)T * 256 * 2;
constexpr size_t W_BIAST = W_SFIN + (size_t)2 * 128 * 64 * 64 * 8;
constexpr size_t W_INVR = W_BIAST + 16 * 128 * 4;
constexpr size_t W_BAR = W_INVR + (size_t)T * 4 + 1024;
constexpr size_t W_END = W_BAR + 3456 * 4;

struct Params {
    const float* in[30];
    float* out;
    unsigned char* ws;
    int ph_lo, ph_hi;
};
typedef __attribute__((address_space(4))) const Params* CP;
__device__ __forceinline__ CP launder(CP p) { asm volatile("" : "+s"(p)); return p; }

__device__ __forceinline__ unsigned cvt_pk_bf16(float lo, float hi) { unsigned r; asm volatile("v_cvt_pk_bf16_f32 %0, %1, %2" : "=v"(r) : "v"(lo), "v"(hi)); return r; }
__device__ __forceinline__ bf16_t f2bf(float f) { return (bf16_t)(cvt_pk_bf16(f, 0.f) & 0xffffu); }
__device__ __forceinline__ float bf2f(unsigned b) { return __uint_as_float(b << 16); }
__device__ __forceinline__ float bflo(unsigned w) { return __uint_as_float(w << 16); }
__device__ __forceinline__ float bfhi(unsigned w) { return __uint_as_float(w & 0xffff0000u); }
#define swz_xor(v, pat) __int_as_float(__builtin_amdgcn_ds_swizzle(__float_as_int(v), (pat)))
__device__ __forceinline__ float xor32(float v, int lane) { return __int_as_float(__builtin_amdgcn_ds_bpermute((lane ^ 32) << 2, __float_as_int(v))); }
__device__ __forceinline__ float wave_sum(float v, int lane) {
    v += swz_xor(v, 0x041f); v += swz_xor(v, 0x081f); v += swz_xor(v, 0x101f); v += swz_xor(v, 0x201f); v += swz_xor(v, 0x401f);
    return v + xor32(v, lane);
}
__device__ __forceinline__ float wave_max(float v, int lane) {
    v = fmaxf(v, swz_xor(v, 0x041f)); v = fmaxf(v, swz_xor(v, 0x081f)); v = fmaxf(v, swz_xor(v, 0x101f)); v = fmaxf(v, swz_xor(v, 0x201f)); v = fmaxf(v, swz_xor(v, 0x401f));
    return fmaxf(v, xor32(v, lane));
}
__device__ __forceinline__ float fast_sigmoid(float x) { return __builtin_amdgcn_rcpf(1.0f + __expf(-x)); }

namespace pg8 {
constexpr int BM = 256, BK = 64, HALF = 128, HTB = HALF * BK * 2, STAGE_BYTES = 8 * HTB, NXCD = 8, WGM = 8;
__device__ __forceinline__ int lds_byte(int r, int c) { const int st = (r >> 4) * 2 + (c >> 5), rr = r & 15, cc = c & 31, ob = rr * 64 + cc * 2; return st * 1024 + (ob ^ (((ob >> 9) & 1) << 5)); }
__device__ __forceinline__ void stage_rc(int b, int& R, int& C) { const int st = b / 1024, sb = b % 1024, swz = sb ^ (((sb >> 9) & 1) << 5); R = (st >> 1) * 16 + swz / 64; C = (st & 1) * 32 + (swz % 64) / 2; }
__device__ __forceinline__ int perm32(int rho) { const int n = rho >> 4, i = rho & 15; return 8 * (i >> 2) + 4 * n + (i & 3); }

struct Unit { int pm, pn; };

struct StaticOrder {
    int nM, nN, nwg, G, c;
    __device__ void init(int M, int N, int G_, int c_) { nM = M / BM; nN = N / BM; nwg = nM * nN; G = G_; c = c_; }
    __device__ bool next(int i, Unit& u) const {
        const long L = (long)i * G + c; if (L >= nwg) return false;
        int wgid = (int)L; { const int q = nwg / NXCD, r = nwg % NXCD, xcd = wgid % NXCD, off = wgid / NXCD; wgid = (xcd < r ? xcd * (q + 1) : r * (q + 1) + (xcd - r) * q) + off; }
        const int nig = WGM * nN, gid = wgid / nig, fm = gid * WGM, gsz = (nM - fm) < WGM ? (nM - fm) : WGM;
        u.pm = fm + ((wgid % nig) % gsz); u.pn = (wgid % nig) / gsz; return true;
    }
};

template <class Epi>
__device__ __forceinline__ void gemm_phase(const int tid, LAS unsigned char* lds, const bf16_t* gA, const bf16_t* gBt, const int gM, const int gN, const int gK, const int gridn, const int cidx,
                                           bf16_t* eO, const int eldc, const float* ebias, const float escale, float* eout, const int enout) {
    StaticOrder S; S.init(gM, gN, gridn, cidx);
    struct { const bf16_t* A; const bf16_t* Bt; int K; } g{gA, gBt, gK};
    const int wid = __builtin_amdgcn_readfirstlane(tid >> 6), lane = tid & 63, wr = wid >> 2, wc = wid & 3, fr = lane & 15, fq = lane >> 4;
    const int K = g.K, nt = K / BK;
    unsigned voffA[2], voffB[2];
#pragma unroll
    for (int i = 0; i < 2; ++i) { int R, C; stage_rc(tid * 16 + i * 8192, R, C); const int Rb = Epi::PERM ? ((R & ~31) + perm32(R & 31)) : R;
        voffA[i] = (unsigned)(R * K + C) * 2u; voffB[i] = (unsigned)(Rb * K + C) * 2u; }
    const size_t kstep = (size_t)(BK * 2);
    const size_t hstep = (size_t)HALF * K * 2;
    const size_t tstep = 2 * hstep;
    const unsigned ldsw = (unsigned)wid * 1024u;
    const int aoff = lds_byte(wr * 64 + fr, fq * 8), boff = lds_byte(wc * 32 + fr, fq * 8);
#define PG8_SA(b, h) (((b) * 2 + (h)) * HTB)
#define PG8_SB(b, h) ((4 + (b) * 2 + (h)) * HTB)
#define PG8_STAGE(bufoff, gbase, voff) do { _Pragma("unroll") for (int _i = 0; _i < 2; ++_i) \
        __builtin_amdgcn_global_load_lds((const unsigned*)((const char*)(gbase) + (voff)[_i]), (LAS unsigned*)(lds + (bufoff) + ldsw + _i * 8192), 16, 0, 0); } while (0)
#define PG8_LDA(dst, b, h) do { _Pragma("unroll") for (int m = 0; m < 4; ++m) _Pragma("unroll") for (int k = 0; k < 2; ++k) dst[m][k] = *(const LAS bf16x8*)(lds + PG8_SA(b, h) + aoff + m * 2048 + k * 1024); } while (0)
#define PG8_LDB(dst, b, h) do { _Pragma("unroll") for (int n = 0; n < 2; ++n) _Pragma("unroll") for (int k = 0; k < 2; ++k) dst[n][k] = *(const LAS bf16x8*)(lds + PG8_SB(b, h) + boff + n * 2048 + k * 1024); } while (0)
#define PG8_MMA(ai, bj, At, Bt) do { __builtin_amdgcn_s_setprio(1); _Pragma("unroll") for (int m = 0; m < 4; ++m) _Pragma("unroll") for (int n = 0; n < 2; ++n) _Pragma("unroll") for (int k = 0; k < 2; ++k) \
        acc[ai][bj][m][n] = __builtin_amdgcn_mfma_f32_16x16x32_bf16(Bt[n][k], At[m][k], acc[ai][bj][m][n], 0, 0, 0); __builtin_amdgcn_s_setprio(0); } while (0)
#define PG8_WAIT_V(n) asm volatile("s_waitcnt vmcnt(" #n ")" ::: "memory")
#define PG8_WAIT_L(n) asm volatile("s_waitcnt lgkmcnt(" #n ")" ::: "memory")
#define PG8_BAR __builtin_amdgcn_s_barrier()
#define PG8_SCHED __builtin_amdgcn_sched_barrier(0)
    Unit cur, nxt; int ui = 0;
    if (!S.next(0, cur)) return;
    f32x4 acc[2][2][4][2];
#pragma unroll
    for (int a = 0; a < 2; ++a)
#pragma unroll
        for (int b = 0; b < 2; ++b)
#pragma unroll
            for (int m = 0; m < 4; ++m)
#pragma unroll
                for (int n = 0; n < 2; ++n) acc[a][b][m][n] = (f32x4){0.f, 0.f, 0.f, 0.f};
    bf16x8 At[4][2], B0[2][2], B1[2][2];
    const char* cA = (const char*)g.A + (size_t)cur.pm * tstep; const char* cB = (const char*)g.Bt + (size_t)cur.pn * tstep;
    PG8_STAGE(PG8_SB(0, 0), cB, voffB); PG8_STAGE(PG8_SA(0, 0), cA, voffA); PG8_STAGE(PG8_SB(0, 1), cB + hstep, voffB); PG8_STAGE(PG8_SA(0, 1), cA + hstep, voffA);
    if (wr == 1) PG8_BAR;
    PG8_WAIT_V(4); PG8_BAR;
    PG8_STAGE(PG8_SB(1, 0), cB + kstep, voffB); PG8_STAGE(PG8_SA(1, 0), cA + kstep, voffA); PG8_STAGE(PG8_SB(1, 1), cB + hstep + kstep, voffB);
    PG8_WAIT_V(6); PG8_BAR;
    for (;;) {
        const bool has_next = S.next(ui + 1, nxt);
        const char* nA = has_next ? (const char*)g.A + (size_t)nxt.pm * tstep : cA; const char* nB = has_next ? (const char*)g.Bt + (size_t)nxt.pn * tstep : cB;
        for (int t = 0; t < nt; t += 2) {
            const bool last = (t == nt - 2);
            const char* a1 = cA + (size_t)(t + 1) * kstep;
            const char* a2 = last ? nA : cA + (size_t)(t + 2) * kstep; const char* b2 = last ? nB : cB + (size_t)(t + 2) * kstep;
            const char* a3 = a2 + kstep; const char* b3 = b2 + kstep;
            PG8_LDB(B0, 0, 0); PG8_SCHED; PG8_LDA(At, 0, 0); PG8_STAGE(PG8_SA(1, 1), a1 + hstep, voffA);
            PG8_WAIT_L(8); PG8_BAR; PG8_WAIT_L(0); PG8_MMA(0, 0, At, B0); PG8_BAR; PG8_SCHED;
            PG8_LDB(B1, 0, 1); PG8_STAGE(PG8_SB(0, 0), b2, voffB);
            PG8_BAR; PG8_WAIT_L(0); PG8_MMA(0, 1, At, B1); PG8_BAR;
            PG8_LDA(At, 0, 1); PG8_STAGE(PG8_SA(0, 0), a2, voffA);
            PG8_BAR; PG8_WAIT_L(0); PG8_MMA(1, 0, At, B0); PG8_BAR; PG8_SCHED;
            PG8_STAGE(PG8_SB(0, 1), b2 + hstep, voffB);
            PG8_WAIT_V(6); PG8_BAR; PG8_MMA(1, 1, At, B1); PG8_BAR;
            PG8_LDB(B0, 1, 0); PG8_SCHED; PG8_LDA(At, 1, 0); PG8_STAGE(PG8_SA(0, 1), a2 + hstep, voffA);
            PG8_WAIT_L(8); PG8_BAR; PG8_WAIT_L(0); PG8_MMA(0, 0, At, B0); PG8_BAR; PG8_SCHED;
            PG8_LDB(B1, 1, 1); PG8_STAGE(PG8_SB(1, 0), b3, voffB);
            PG8_BAR; PG8_WAIT_L(0); PG8_MMA(0, 1, At, B1); PG8_BAR;
            PG8_LDA(At, 1, 1); PG8_STAGE(PG8_SA(1, 0), a3, voffA);
            PG8_BAR; PG8_WAIT_L(0); PG8_MMA(1, 0, At, B0); PG8_BAR; PG8_SCHED;
            PG8_STAGE(PG8_SB(1, 1), b3 + hstep, voffB);
            PG8_WAIT_V(6); PG8_BAR; PG8_MMA(1, 1, At, B1); PG8_BAR;
        }
        Epi::run(acc, cur, wr, wc, fr, fq, eO, eldc, ebias, escale, eout, enout);
        if (!has_next) break;
#pragma unroll
        for (int a = 0; a < 2; ++a)
#pragma unroll
            for (int b = 0; b < 2; ++b)
#pragma unroll
                for (int m = 0; m < 4; ++m)
#pragma unroll
                    for (int n = 0; n < 2; ++n) acc[a][b][m][n] = (f32x4){0.f, 0.f, 0.f, 0.f};
        cur = nxt; cA = nA; cB = nB; ++ui;
    }
    PG8_WAIT_V(0);
    if (wr == 0) PG8_BAR;
    PG8_BAR;
#undef PG8_SA
#undef PG8_SB
#undef PG8_STAGE
#undef PG8_LDA
#undef PG8_LDB
#undef PG8_MMA
#undef PG8_WAIT_V
#undef PG8_WAIT_L
#undef PG8_BAR
#undef PG8_SCHED
}

template <int MODE> struct EpiGated {
    static constexpr bool PERM = true;
    static __device__ __forceinline__ void run(const f32x4 (&acc)[2][2][4][2], const Unit& u, int wr, int wc, int fr, int fq, bf16_t* O, int ldc, const float* bias, float scale, float* out, int nout) {
        const int row0 = u.pm * BM + wr * 64 + fr, col0 = u.pn * HALF + wc * 32 + 8 * fq;
        f32x4 ba[2], bb[2];
        if (MODE == 1) {
#pragma unroll
            for (int n = 0; n < 2; ++n) { ba[n] = *(const f32x4*)(bias + col0 + 4 * n); bb[n] = *(const f32x4*)(bias + nout + col0 + 4 * n); }
        }
#pragma unroll
        for (int ai = 0; ai < 2; ++ai)
#pragma unroll
            for (int m = 0; m < 4; ++m) {
                bf16_t* rowp = O + (size_t)(row0 + ai * HALF + m * 16) * ldc + col0;
                float o[8];
                if (MODE == 0) {
#pragma unroll
                    for (int n = 0; n < 2; ++n)
#pragma unroll
                        for (int h = 0; h < 2; ++h) {
                            const f32x2 a = (f32x2){acc[ai][0][m][n][2 * h], acc[ai][0][m][n][2 * h + 1]}, b = (f32x2){acc[ai][1][m][n][2 * h], acc[ai][1][m][n][2 * h + 1]};
                            const f32x2 t = a * (-1.4426950408889634f);
                            f32x2 e; e.x = __builtin_amdgcn_exp2f(t.x); e.y = __builtin_amdgcn_exp2f(t.y);
                            const f32x2 d = e + 1.0f;
                            f32x2 r; r.x = __builtin_amdgcn_rcpf(d.x); r.y = __builtin_amdgcn_rcpf(d.y);
                            const f32x2 v = (a * b) * r;
                            o[4 * n + 2 * h] = v.x; o[4 * n + 2 * h + 1] = v.y;
                        }
                } else {
#pragma unroll
                    for (int n = 0; n < 2; ++n)
#pragma unroll
                        for (int j = 0; j < 4; ++j) { const float a = acc[ai][0][m][n][j], b = acc[ai][1][m][n][j]; o[4 * n + j] = (a + ba[n][j]) * fast_sigmoid(b + bb[n][j]); }
                }
                u32x4 w; w.x = cvt_pk_bf16(o[0], o[1]); w.y = cvt_pk_bf16(o[2], o[3]); w.z = cvt_pk_bf16(o[4], o[5]); w.w = cvt_pk_bf16(o[6], o[7]);
                *(u32x4*)rowp = w;
            }
    }
};
template <int KV> struct EpiBf16 {
    static constexpr bool PERM = true;
    static __device__ __forceinline__ void run(const f32x4 (&acc)[2][2][4][2], const Unit& u, int wr, int wc, int fr, int fq, bf16_t* O, int ldc, const float* bias, float scale, float* out, int nout) {
        const int row0 = u.pm * BM + wr * 64 + fr, col0 = u.pn * BM + wc * 32 + 8 * fq;
        f32x4 bv[2][2];
#pragma unroll
        for (int bj = 0; bj < 2; ++bj)
#pragma unroll
            for (int n = 0; n < 2; ++n) bv[bj][n] = bias ? *(const f32x4*)(bias + col0 + bj * HALF + 4 * n) : (f32x4){0.f, 0.f, 0.f, 0.f};
#pragma unroll
        for (int ai = 0; ai < 2; ++ai)
#pragma unroll
            for (int m = 0; m < 4; ++m) {
                const int row = row0 + ai * HALF + m * 16;
                bf16_t* rowp = O + (size_t)row * ldc + col0;
                float* wrow = nullptr;
                size_t vdelta = 0;
                if (KV) {
                    if (row < TP) { const int b = row >> 13, s = row & (SEQ - 1); if (s >= SEQ - WIN) { wrow = out + O_KP + ((size_t)b * WIN + (s - (SEQ - WIN))) * 128; vdelta = O_VP - O_KP; } }
                    else { const int rr = row - TP, b = rr >> 2, t = rr & 3; wrow = out + O_KS + ((size_t)b * WIN + (WIN - 4 + t)) * 128; vdelta = O_VS - O_KS; }
                }
#pragma unroll
                for (int bj = 0; bj < 2; ++bj) {
                    const f32x4 v0 = (acc[ai][bj][m][0] + bv[bj][0]) * scale, v1 = (acc[ai][bj][m][1] + bv[bj][1]) * scale;
                    u32x4 w; w.x = cvt_pk_bf16(v0[0], v0[1]); w.y = cvt_pk_bf16(v0[2], v0[3]); w.z = cvt_pk_bf16(v1[0], v1[1]); w.w = cvt_pk_bf16(v1[2], v1[3]);
                    *(u32x4*)(rowp + bj * HALF) = w;
                    if (KV) { if (wrow) { float* dst = wrow + (bj ? vdelta : 0) + (col0 & 127);
                        *(f32x4*)dst = v0; *(f32x4*)(dst + 4) = v1; } }
                }
            }
    }
};
}


constexpr int SGS = 68;
template <int GATED>
__device__ __forceinline__ void small_gemm(const int tid, const int bid, const int nblk, LAS unsigned char* lds, const bf16_t* A, const bf16_t* Bt, const int N, const int K,
                                           bf16_t* O, const int ldc, const float* bias, const float scale, const int nout) {
    const int lane = tid & 63, wave = __builtin_amdgcn_readfirstlane(tid >> 6), fr = lane & 15, fq = lane >> 4;
    LAS float* part = (LAS float*)lds;
    const int ncol = GATED ? nout / 32 : N / 64, nunits = (TS / 32) * ncol;
    const int kw = K / 8, nks = kw / 32;
    for (int unit = bid; unit < nunits; unit += nblk) {
        const int rt = unit / ncol, ct = unit % ncol;
        const int r0 = TP + rt * 32;
        int brow[4];
#pragma unroll
        for (int f = 0; f < 4; ++f) {
            if (GATED) { const int oc0 = ct * 32, base = (oc0 >> 7) * 256 + (oc0 & 127); brow[f] = base + (f >> 1) * 128 + (f & 1) * 16 + fr; }
            else brow[f] = ct * 64 + f * 16 + fr;
        }
        const bf16_t* ap0 = A + (size_t)(r0 + fr) * K + wave * kw + fq * 8;
        const bf16_t* ap1 = ap0 + (size_t)16 * K;
        const bf16_t* bp[4];
#pragma unroll
        for (int f = 0; f < 4; ++f) bp[f] = Bt + (size_t)brow[f] * K + wave * kw + fq * 8;
        f32x4 acc[2][4];
#pragma unroll
        for (int i = 0; i < 2; ++i)
#pragma unroll
            for (int f = 0; f < 4; ++f) acc[i][f] = (f32x4){0.f, 0.f, 0.f, 0.f};
        bf16x8 pa0[3], pa1[3], pb[3][4], qa0[3], qa1[3], qb[3][4];
#define SG_LOAD(A0, A1, B, KS) do { _Pragma("unroll") for (int u = 0; u < 3; ++u) if ((KS) + u < nks) { const int ko = ((KS) + u) * 32; \
            A0[u] = *(const bf16x8*)(ap0 + ko); A1[u] = *(const bf16x8*)(ap1 + ko); _Pragma("unroll") for (int f = 0; f < 4; ++f) B[u][f] = *(const bf16x8*)(bp[f] + ko); } } while (0)
#define SG_MMA(A0, A1, B, KS) do { _Pragma("unroll") for (int u = 0; u < 3; ++u) if ((KS) + u < nks) { _Pragma("unroll") for (int f = 0; f < 4; ++f) { \
            acc[0][f] = __builtin_amdgcn_mfma_f32_16x16x32_bf16(A0[u], B[u][f], acc[0][f], 0, 0, 0); acc[1][f] = __builtin_amdgcn_mfma_f32_16x16x32_bf16(A1[u], B[u][f], acc[1][f], 0, 0, 0); } } } while (0)
        SG_LOAD(pa0, pa1, pb, 0);
        if (3 < nks) SG_LOAD(qa0, qa1, qb, 3);
        for (int ks0 = 0; ks0 < nks; ks0 += 6) {
            SG_MMA(pa0, pa1, pb, ks0);
            if (ks0 + 6 < nks) SG_LOAD(pa0, pa1, pb, ks0 + 6);
            if (ks0 + 3 < nks) SG_MMA(qa0, qa1, qb, ks0 + 3);
            if (ks0 + 9 < nks) SG_LOAD(qa0, qa1, qb, ks0 + 9);
        }
#undef SG_LOAD
#undef SG_MMA
        __syncthreads();
#pragma unroll
        for (int i = 0; i < 2; ++i)
#pragma unroll
            for (int f = 0; f < 4; ++f)
#pragma unroll
                for (int j = 0; j < 4; ++j) part[(wave * 32 + 16 * i + 4 * fq + j) * SGS + 16 * f + fr] = acc[i][f][j];
        __syncthreads();
        const int row = tid >> 4, c4 = (tid & 15) * 4;
        f32x4 sum = (f32x4){0.f, 0.f, 0.f, 0.f};
#pragma unroll
        for (int w = 0; w < 8; ++w) sum += *(const LAS f32x4*)(part + (w * 32 + row) * SGS + c4);
        if (!GATED) {
            const int col = ct * 64 + c4;
            f32x4 bv = bias ? *(const f32x4*)(bias + col) : (f32x4){0.f, 0.f, 0.f, 0.f};
            const f32x4 v = (sum + bv) * scale;
            u32x2 w; w.x = cvt_pk_bf16(v[0], v[1]); w.y = cvt_pk_bf16(v[2], v[3]);
            *(u32x2*)(O + (size_t)(r0 + row) * ldc + col) = w;
        } else {
            if (c4 < 32) {
                f32x4 sb = (f32x4){0.f, 0.f, 0.f, 0.f};
#pragma unroll
                for (int w = 0; w < 8; ++w) sb += *(const LAS f32x4*)(part + (w * 32 + row) * SGS + 32 + c4);
                const int col = ct * 32 + c4;
                const f32x4 ba = *(const f32x4*)(bias + col), bb = *(const f32x4*)(bias + nout + col);
                float o[4];
#pragma unroll
                for (int j = 0; j < 4; ++j) o[j] = (sum[j] + ba[j]) * fast_sigmoid(sb[j] + bb[j]);
                u32x2 w; w.x = cvt_pk_bf16(o[0], o[1]); w.y = cvt_pk_bf16(o[2], o[3]);
                *(u32x2*)(O + (size_t)(r0 + row) * ldc + col) = w;
            }
        }
    }
    __syncthreads();
}

constexpr int CTS = 266;
__device__ __forceinline__ void cvt_block_item(const float* W, int K, int Nsrc, bf16_t* WT, int Ndst, int inter, int halfoff, const float* gk, LAS unsigned char* lds, int item, int tid) {
    const int lane = tid & 63, wave = __builtin_amdgcn_readfirstlane(tid >> 6);
    const int nb256 = Ndst / 256, kb = item / nb256, nb = item % nb256, k0 = 64 * kb, r0 = 256 * nb;
    LAS unsigned* Tl = (LAS unsigned*)lds;
    const int r = r0 + 4 * lane, c = inter ? ((r >> 8) * 128 + (r & 127) + ((r >> 7) & 1) * halfoff) : r;
    const float* src = W + (size_t)(k0 + wave * 8) * Nsrc + c;
    f32x4 v[8];
#pragma unroll
    for (int i = 0; i < 8; ++i) v[i] = *(const f32x4*)(src + (size_t)i * Nsrc);
#pragma unroll
    for (int i = 0; i < 8; ++i) { const float gs = gk ? gk[k0 + wave * 8 + i] : 1.0f;
        LAS unsigned* d = Tl + (wave * 8 + i) * (CTS / 2) + 2 * lane;
        d[0] = cvt_pk_bf16(v[i].x * gs, v[i].y * gs); d[1] = cvt_pk_bf16(v[i].z * gs, v[i].w * gs); }
    __syncthreads();
    const LAS bf16_t* Tb = (const LAS bf16_t*)lds;
    const int ch = tid & 7;
#pragma unroll
    for (int i = 0; i < 4; ++i) { const int n = i * 64 + (tid >> 3); const LAS bf16_t* t = Tb + (ch * 8) * CTS + n;
        u32x4 o;
        o.x = (unsigned)t[0 * CTS] | ((unsigned)t[1 * CTS] << 16); o.y = (unsigned)t[2 * CTS] | ((unsigned)t[3 * CTS] << 16);
        o.z = (unsigned)t[4 * CTS] | ((unsigned)t[5 * CTS] << 16); o.w = (unsigned)t[6 * CTS] | ((unsigned)t[7 * CTS] << 16);
        *(u32x4*)(WT + (size_t)(r0 + n) * K + k0 + ch * 8) = o; }
    __syncthreads();
}

__device__ __forceinline__ int t5_bucket(int n) {
    if (n < 16) return n;
    int large = 16 + (int)(logf((float)n / 16.0f) / 2.0794415416798357f * 16.0f);
    return large < 31 ? large : 31;
}

__device__ __forceinline__ void store_xhat(const f32x4 (&v)[4], bf16_t* xbrow, float* invr, int lane) {
    float s = 0.f;
#pragma unroll
    for (int j = 0; j < 4; ++j) s += (v[j].x * v[j].x + v[j].y * v[j].y) + (v[j].z * v[j].z + v[j].w * v[j].w);
    const float ms = wave_sum(s, lane) * (1.0f / D) + RMS_EPS;
    const float rstd = rsqrtf(ms);
    if (lane == 0) *invr = sqrtf(ms);
    u32x2* o8 = (u32x2*)xbrow + lane;
#pragma unroll
    for (int j = 0; j < 4; ++j) { u32x2 w; w.x = cvt_pk_bf16(v[j].x * rstd, v[j].y * rstd); w.y = cvt_pk_bf16(v[j].z * rstd, v[j].w * rstd); o8[64 * j] = w; }
}

__device__ __forceinline__ void cvt_layer(CP P, const int tid, LAS unsigned char* lds, const int layer, const int half, const int widx, const int nw) {
    unsigned char* ws = P->ws;
    int base = 0;
    for (int job = 0; job < 23; ++job) {
        const float* src; int K, Nsrc, Ndst, inter = 0, halfoff = 0, jl, jh; bf16_t* dst; const float* gk = nullptr;
        if (job < 8) { const int l = job >> 1, f = job & 1; jl = l; jh = f; src = P->in[f ? 9 : 7] + (size_t)l * D * 2 * FF; K = D; Nsrc = 2 * FF; Ndst = 2 * FF; inter = 1; halfoff = FF;
            dst = (bf16_t*)(ws + W_GU) + (size_t)job * 2 * FF * D; gk = P->in[6] + (l * 6 + (f ? 4 : 0)) * D; }
        else if (job < 16) { const int j = job - 8, l = j >> 1, f = j & 1; jl = l; jh = f; src = P->in[f ? 10 : 8] + (size_t)l * FF * D; K = FF; Nsrc = D; Ndst = D; dst = (bf16_t*)(ws + W_DN) + (size_t)j * D * FF; }
        else if (job < 18) { const int l = job - 16; jl = l; jh = 0; src = P->in[19] + (size_t)l * D * 2 * D; K = D; Nsrc = 2 * D; Ndst = 2 * D; inter = 1; halfoff = D; dst = (bf16_t*)(ws + W_GLU) + (size_t)l * 2 * D * D; }
        else if (job < 20) { const int bl = job - 18; jl = 2 + bl; jh = 0; src = P->in[24] + (size_t)bl * D * D; K = D; Nsrc = D; Ndst = D; dst = (bf16_t*)(ws + W_Q) + (size_t)bl * D * D; gk = P->in[6] + ((2 + bl) * 6 + 2) * D; }
        else if (job < 22) { const int bl = job - 20; jl = 2 + bl; jh = 0; src = P->in[27] + (size_t)bl * D * D; K = D; Nsrc = D; Ndst = D; dst = (bf16_t*)(ws + W_O) + (size_t)bl * D * D; }
        else { jl = 2; jh = 1; src = P->in[22]; K = D; Nsrc = 256; Ndst = 256; dst = (bf16_t*)(ws + W_KV); gk = P->in[21]; }
        if (jl != layer || (half >= 0 && jh != half)) continue;
        const int nitems = (K / 64) * (Ndst / 256);
        int first = (widx - base) % nw; if (first < 0) first += nw;
        for (int it = first; it < nitems; it += nw) cvt_block_item(src, K, Nsrc, dst, Ndst, inter, halfoff, gk, lds, it, tid);
        base += nitems;
    }
}
__device__ __forceinline__ void cvt_in_shadow(CP P, const int tid, const int bid, const int nblk, LAS unsigned char* lds, const int layer, const int half) {
    const int rem = (66 * 22) % nblk, lo = rem ? rem : 0;
    if (bid < lo) return;
    cvt_layer(P, tid, lds, layer, half, bid - lo, nblk - lo);
}

__device__ __forceinline__ void phase_prologue(CP P, const int tid, const int bid, const int nblk, LAS unsigned char* lds) {
    const int lane = tid & 63, wave = __builtin_amdgcn_readfirstlane(tid >> 6);
    const int gw = bid * NWAVES + wave, NGW = nblk * NWAVES;
    unsigned char* ws = P->ws;
    cvt_layer(P, tid, lds, 0, -1, bid, nblk);
    {
        f32x4 nv[4];
        if (gw < T) { const float* src = gw < TP ? P->in[0] + (size_t)gw * D : P->in[1] + (size_t)(gw - TP) * D;
#pragma unroll
            for (int j = 0; j < 4; ++j) nv[j] = ((const f32x4*)src)[lane + 64 * j]; }
        for (int row = gw; row < T; row += NGW) {
            f32x4 v[4];
#pragma unroll
            for (int j = 0; j < 4; ++j) v[j] = nv[j];
            const int nr = row + NGW;
            if (nr < T) { const float* src = nr < TP ? P->in[0] + (size_t)nr * D : P->in[1] + (size_t)(nr - TP) * D;
#pragma unroll
                for (int j = 0; j < 4; ++j) nv[j] = ((const f32x4*)src)[lane + 64 * j]; }
            store_xhat(v, (bf16_t*)(ws + W_XB) + (size_t)row * D, (float*)(ws + W_INVR) + row, lane);
        }
    }
    const int gt = bid * NTHREADS + tid, NGT = nblk * NTHREADS;
    for (int i = gt; i < 16 * 128; i += NGT) { const int h = i >> 7, d = i & 127; ((float*)(ws + W_BIAST))[i] = P->in[29][t5_bucket(d) * 16 + h]; }
    for (int i = gt; i < 128 * 124 * 32; i += NGT) { const int c4 = i & 31, r = (i >> 5) % 124, b = (i >> 5) / 124;
        const size_t so = ((size_t)b * WIN + r + 4) * 128 + c4 * 4, dq = ((size_t)b * WIN + r) * 128 + c4 * 4;
        *(f32x4*)(P->out + O_KS + dq) = *(const f32x4*)(P->in[4] + so); *(f32x4*)(P->out + O_VS + dq) = *(const f32x4*)(P->in[5] + so); }
}

__device__ __forceinline__ void phase_fixup(CP P, const int tid, const int bid, const int nblk, float alpha, const float* gpost, const bool last) {
    const int lane = tid & 63, wave = tid >> 6;
    const int gw = bid * NWAVES + wave, NGW = nblk * NWAVES;
    const bf16_t* Fb = (const bf16_t*)(P->ws + W_F);
    bf16_t* XR = (bf16_t*)(P->ws + W_XB);
    float* invr = (float*)(P->ws + W_INVR);
    f32x4 gv[4];
#pragma unroll
    for (int j = 0; j < 4; ++j) gv[j] = ((const f32x4*)gpost)[lane + 64 * j];
    u32x2 nf[4], nx[4]; float nsc = 0.f;
    if (gw < T) {
        const u32x2* fr = (const u32x2*)(Fb + (size_t)gw * D) + lane; const u32x2* xr = (const u32x2*)(XR + (size_t)gw * D) + lane;
#pragma unroll
        for (int j = 0; j < 4; ++j) { nf[j] = fr[64 * j]; nx[j] = xr[64 * j]; }
        nsc = invr[gw];
    }
    for (int row = gw; row < T; row += NGW) {
        u32x2 cf[4], cx[4]; const float csc = nsc;
#pragma unroll
        for (int j = 0; j < 4; ++j) { cf[j] = nf[j]; cx[j] = nx[j]; }
        if (row + NGW < T) {
            const u32x2* fr = (const u32x2*)(Fb + (size_t)(row + NGW) * D) + lane; const u32x2* xr = (const u32x2*)(XR + (size_t)(row + NGW) * D) + lane;
#pragma unroll
            for (int j = 0; j < 4; ++j) { nf[j] = fr[64 * j]; nx[j] = xr[64 * j]; }
            nsc = invr[row + NGW];
        }
        f32x4 f[4], v[4]; float s = 0.f;
#pragma unroll
        for (int j = 0; j < 4; ++j) { const u32x2 w = cf[j]; f[j] = (f32x4){bflo(w.x), bfhi(w.x), bflo(w.y), bfhi(w.y)};
            const u32x2 q = cx[j]; v[j] = (f32x4){bflo(q.x), bfhi(q.x), bflo(q.y), bfhi(q.y)} * csc;
            s += (f[j].x * f[j].x + f[j].y * f[j].y) + (f[j].z * f[j].z + f[j].w * f[j].w); }
        const float rs = rsqrtf(wave_sum(s, lane) * (1.0f / D) + RMS_EPS) * alpha;
#pragma unroll
        for (int j = 0; j < 4; ++j) v[j] += f[j] * gv[j] * rs;
        if (last) { f32x4* xo = (f32x4*)(P->out + O_Y + (size_t)row * D);
#pragma unroll
            for (int j = 0; j < 4; ++j) xo[lane + 64 * j] = v[j]; }
        else store_xhat(v, XR + (size_t)row * D, invr + row, lane);
    }
}

struct SsmCoef { float lbr, lbi; float Br[16], Bi[16]; };
__device__ __forceinline__ void ssm_coef(CP P, int l, int g, int p, SsmCoef& c) {
    const int idx = (l * NG + g) * NP + p;
    const float lr = P->in[11][idx], li = P->in[12][idx], dt = expf(P->in[13][idx]);
    const float a = lr * dt, th = li * dt;
    float sn, cs; sincosf(th, &sn, &cs);
    const float e = expf(a);
    c.lbr = e * cs; c.lbi = e * sn;
    float sh, ch; sincosf(0.5f * th, &sh, &ch);
    const float m1r = expm1f(a) * cs - 2.0f * sh * sh, m1i = c.lbi;
    const float den = 1.0f / (lr * lr + li * li);
    const float cr = (m1r * lr + m1i * li) * den, ci = (m1i * lr - m1r * li) * den;
    const f32x4* br = (const f32x4*)(P->in[14] + (size_t)idx * 16); const f32x4* bi = (const f32x4*)(P->in[15] + (size_t)idx * 16);
#pragma unroll
    for (int q = 0; q < 4; ++q) { const f32x4 r = br[q], i = bi[q];
#pragma unroll
        for (int j = 0; j < 4; ++j) { c.Br[4 * q + j] = cr * r[j] - ci * i[j]; c.Bi[4 * q + j] = cr * i[j] + ci * r[j]; } }
}
typedef short bf16x4s __attribute__((ext_vector_type(4)));
constexpr int USB = 136;
constexpr int BUS = 132;
constexpr int XSS = 136;
constexpr int SSM_WAVE_LDS = 16 * BUS * 4 + 16 * XSS * 2;
constexpr int SSM_U_LDS = 64 * USB * 2;

__device__ __forceinline__ void ssm_fetch_u(CP P, const int tid, int row0, int gs, u32x4 (&w)[2]) {
    const bf16_t* xb = (const bf16_t*)(P->ws + W_XB);
#pragma unroll
    for (int i = 0; i < 2; ++i) { const int idx = tid + NTHREADS * i, t = idx >> 4, c8 = idx & 15; w[i] = *(const u32x4*)(xb + (size_t)(row0 + t) * D + gs * 128 + c8 * 8); }
}
__device__ __forceinline__ void ssm_put_u(CP P, const int tid, int l, int gs, const u32x4 (&wv)[2], LAS bf16_t* uT) {
    const float* g2 = P->in[6] + (l * 6 + 2) * D + gs * 128;
#pragma unroll
    for (int i = 0; i < 2; ++i) { const int idx = tid + NTHREADS * i, t = idx >> 4, c8 = idx & 15; const u32x4 w = wv[i];
        const f32x4 ga = *(const f32x4*)(g2 + c8 * 8), gb = *(const f32x4*)(g2 + c8 * 8 + 4);
        u32x4 o; o.x = cvt_pk_bf16(bflo(w.x) * ga.x, bfhi(w.x) * ga.y); o.y = cvt_pk_bf16(bflo(w.y) * ga.z, bfhi(w.y) * ga.w);
        o.z = cvt_pk_bf16(bflo(w.z) * gb.x, bfhi(w.z) * gb.y); o.w = cvt_pk_bf16(bflo(w.w) * gb.z, bfhi(w.w) * gb.w);
        *(LAS u32x4*)(uT + t * USB + c8 * 8) = o; }
}
__device__ __forceinline__ void ssm_setup(CP P, int l, int g, int lane, LAS float* buL, float& lbr, float& lbi, bf16x4s (&Bf)[8]) {
    const int fr = lane & 15, fq = lane >> 4;
    SsmCoef cf; ssm_coef(P, l, g, lane, cf);
    lbr = cf.lbr; lbi = cf.lbi;
    LAS bf16_t* BL = (LAS bf16_t*)buL;
    asm volatile("s_waitcnt lgkmcnt(0)" ::: "memory");
    u32x4 w0, w1, w2, w3;
    w0.x = cvt_pk_bf16(cf.Br[0], cf.Br[1]); w0.y = cvt_pk_bf16(cf.Br[2], cf.Br[3]); w0.z = cvt_pk_bf16(cf.Br[4], cf.Br[5]); w0.w = cvt_pk_bf16(cf.Br[6], cf.Br[7]);
    w1.x = cvt_pk_bf16(cf.Br[8], cf.Br[9]); w1.y = cvt_pk_bf16(cf.Br[10], cf.Br[11]); w1.z = cvt_pk_bf16(cf.Br[12], cf.Br[13]); w1.w = cvt_pk_bf16(cf.Br[14], cf.Br[15]);
    w2.x = cvt_pk_bf16(cf.Bi[0], cf.Bi[1]); w2.y = cvt_pk_bf16(cf.Bi[2], cf.Bi[3]); w2.z = cvt_pk_bf16(cf.Bi[4], cf.Bi[5]); w2.w = cvt_pk_bf16(cf.Bi[6], cf.Bi[7]);
    w3.x = cvt_pk_bf16(cf.Bi[8], cf.Bi[9]); w3.y = cvt_pk_bf16(cf.Bi[10], cf.Bi[11]); w3.z = cvt_pk_bf16(cf.Bi[12], cf.Bi[13]); w3.w = cvt_pk_bf16(cf.Bi[14], cf.Bi[15]);
    *(LAS u32x4*)(BL + lane * 16) = w0; *(LAS u32x4*)(BL + lane * 16 + 8) = w1;
    *(LAS u32x4*)(BL + (64 + lane) * 16) = w2; *(LAS u32x4*)(BL + (64 + lane) * 16 + 8) = w3;
    asm volatile("s_waitcnt lgkmcnt(0)" ::: "memory");
#pragma unroll
    for (int nt = 0; nt < 8; ++nt) Bf[nt] = *(const LAS bf16x4s*)(BL + ((nt >> 2) * 64 + 16 * (nt & 3) + fr) * 16 + 4 * fq);
    asm volatile("s_waitcnt lgkmcnt(0)" ::: "memory");
}
__device__ __forceinline__ void ssm_bu(const bf16x4s uf, const bf16x4s (&Bf)[8], LAS float* buL, int fr, int fq) {
#pragma unroll
    for (int nt = 0; nt < 8; ++nt) {
        const f32x4 d = __builtin_amdgcn_mfma_f32_16x16x16bf16_1k(uf, Bf[nt], (f32x4){0.f, 0.f, 0.f, 0.f}, 0, 0, 0);
#pragma unroll
        for (int j = 0; j < 4; ++j) buL[(4 * fq + j) * BUS + 2 * (16 * (nt & 3) + fr) + (nt >> 2)] = d[j];
    }
    asm volatile("s_waitcnt lgkmcnt(0)" ::: "memory");
}

__device__ __forceinline__ void phase_ssm_a(CP P, const int tid, const int bid, const int nblk, int l, LAS unsigned char* lds) {
    const int lane = tid & 63, wave = __builtin_amdgcn_readfirstlane(tid >> 6), fr = lane & 15, fq = lane >> 4;
    LAS bf16_t* uT = (LAS bf16_t*)lds;
    LAS float* buL = (LAS float*)(lds + SSM_U_LDS + wave * SSM_WAVE_LDS);
    f32x2* sfin = (f32x2*)(P->ws + W_SFIN);
    for (int unit = bid; unit < 256; unit += nblk) {
        const int r = unit & 15, gs = (unit >> 4) & 7, b = unit >> 7;
        if (r == 15) continue;
        const int g = gs * 8 + wave;
        u32x4 wpre[2]; ssm_fetch_u(P, tid, b * SEQ + (r * 8) * 64, gs, wpre);
        float lbr, lbi; bf16x4s Bf[8];
        ssm_setup(P, l, g, lane, buL, lbr, lbi, Bf);
        float xr = 0.f, xi = 0.f;
        for (int cc = 0; cc < 8; ++cc) {
            __syncthreads();
            ssm_put_u(P, tid, l, gs, wpre, uT);
            if (cc + 1 < 8) ssm_fetch_u(P, tid, b * SEQ + (r * 8 + cc + 1) * 64, gs, wpre);
            __syncthreads();
            for (int sub = 0; sub < 4; ++sub) {
                const bf16x4s uf = *(const LAS bf16x4s*)(uT + (sub * 16 + fr) * USB + wave * 16 + 4 * fq);
                ssm_bu(uf, Bf, buL, fr, fq);
#pragma unroll
                for (int t = 0; t < 16; ++t) { const f32x2 bb = *(const LAS f32x2*)(buL + t * BUS + 2 * lane);
                    const float nr = lbr * xr - lbi * xi + bb.x, ni = lbr * xi + lbi * xr + bb.y; xr = nr; xi = ni; }
                asm volatile("s_waitcnt lgkmcnt(0)" ::: "memory");
            }
        }
        sfin[((size_t)(b * 16 + r) * NG + g) * NP + lane] = (f32x2){xr, xi};
    }
}

__device__ __forceinline__ float gelu_tanh(float y) {
    const float z = 0.7978845608028654f * (y + 0.044715f * y * y * y);
    return y * fast_sigmoid(2.0f * z);
}

__device__ __forceinline__ void phase_ssm_b(CP P, const int tid, const int bid, const int nblk, int l, LAS unsigned char* lds) {
    const int lane = tid & 63, wave = __builtin_amdgcn_readfirstlane(tid >> 6), fr = lane & 15, fq = lane >> 4;
    LAS bf16_t* uT = (LAS bf16_t*)lds;
    LAS float* buL = (LAS float*)(lds + SSM_U_LDS + wave * SSM_WAVE_LDS);
    LAS bf16_t* XS = (LAS bf16_t*)(lds + SSM_U_LDS + wave * SSM_WAVE_LDS + 16 * BUS * 4);
    const f32x2* sfin = (const f32x2*)(P->ws + W_SFIN);
    bf16_t* GB = (bf16_t*)(P->ws + W_QB);
    const bf16_t* xb = (const bf16_t*)(P->ws + W_XB);
    for (int unit = bid; unit < 512; unit += nblk) {
        const bool sample = unit >= 256;
        int g, b = 0, r = 0, gs = 0, b4 = 0;
        if (!sample) { r = unit & 15; gs = (unit >> 4) & 7; b = unit >> 7; g = gs * 8 + wave; }
        else { const int wt = (unit - 256) * 8 + wave; b4 = wt >> 6; g = wt & 63; }
        u32x4 wpre[2];
        if (!sample) ssm_fetch_u(P, tid, b * SEQ + (r * 8) * 64, gs, wpre);
        float x0r[4], x0i[4];
        if (sample) {
#pragma unroll
            for (int q = 0; q < 4; ++q) { const size_t si = (((size_t)l * 128 + (b4 * 4 + q)) * NG + g) * NP + lane; x0r[q] = P->in[2][si]; x0i[q] = P->in[3][si]; }
        } else {
#pragma unroll
            for (int q = 0; q < 4; ++q) { x0r[q] = 0.f; x0i[q] = 0.f; }
        }
        float lbr, lbi; bf16x4s Bf[8];
        ssm_setup(P, l, g, lane, buL, lbr, lbi, Bf);
        bf16x8 Cf[4];
        {
            const float* cre = P->in[16] + ((size_t)(l * NG + g) * GS + fr) * NP; const float* cim = P->in[17] + ((size_t)(l * NG + g) * GS + fr) * NP;
#pragma unroll
            for (int ks = 0; ks < 4; ++ks) {
                const f32x4 a = *(const f32x4*)(cre + 4 * fq + 16 * ks), bq = *(const f32x4*)(cim + 4 * fq + 16 * ks);
                u32x4 w; w.x = cvt_pk_bf16(a.x, -bq.x); w.y = cvt_pk_bf16(a.y, -bq.y); w.z = cvt_pk_bf16(a.z, -bq.z); w.w = cvt_pk_bf16(a.w, -bq.w);
                Cf[ks] = __builtin_bit_cast(bf16x8, w); }
        }
        const f32x4 dch = *(const f32x4*)(P->in[18] + l * D + g * 16 + 4 * fq);
        float xr = 0.f, xi = 0.f;
        if (!sample) {
            float ar = lbr, ai = lbi;
#pragma unroll
            for (int q = 0; q < 9; ++q) { const float nr = ar * ar - ai * ai, ni = 2.f * ar * ai; ar = nr; ai = ni; }
            const f32x2* sp = sfin + ((size_t)(b * 16) * NG + g) * NP + lane;
            f32x2 sv[15];
#pragma unroll
            for (int j = 0; j < 15; ++j) sv[j] = j < r ? sp[(size_t)j * NG * NP] : (f32x2){0.f, 0.f};
#pragma unroll
            for (int j = 0; j < 15; ++j) if (j < r) { const float nr = ar * xr - ai * xi + sv[j].x, ni = ar * xi + ai * xr + sv[j].y; xr = nr; xi = ni; }
        }
        const int nchunk = sample ? 1 : 8, nsub = sample ? 1 : 4;
        for (int cc = 0; cc < nchunk; ++cc) {
            const int row0 = sample ? TP + b4 * 16 : b * SEQ + (r * 8 + cc) * 64;
            if (!sample) { __syncthreads(); ssm_put_u(P, tid, l, gs, wpre, uT); if (cc + 1 < 8) ssm_fetch_u(P, tid, row0 + 64, gs, wpre); __syncthreads(); }
            for (int sub = 0; sub < nsub; ++sub) {
                bf16x4s uf;
                if (!sample) uf = *(const LAS bf16x4s*)(uT + (sub * 16 + fr) * USB + wave * 16 + 4 * fq);
                else { const u32x2 w = *(const u32x2*)(xb + (size_t)(row0 + fr) * D + g * 16 + 4 * fq);
                    const f32x4 gg = *(const f32x4*)(P->in[6] + (l * 6 + 2) * D + g * 16 + 4 * fq);
                    u32x2 o; o.x = cvt_pk_bf16(bflo(w.x) * gg.x, bfhi(w.x) * gg.y); o.y = cvt_pk_bf16(bflo(w.y) * gg.z, bfhi(w.y) * gg.w);
                    uf = __builtin_bit_cast(bf16x4s, o); }
                ssm_bu(uf, Bf, buL, fr, fq);
#pragma unroll
                for (int t = 0; t < 16; ++t) {
                    if (sample && (t & 3) == 0) { xr = x0r[t >> 2]; xi = x0i[t >> 2]; }
                    const f32x2 bb = *(const LAS f32x2*)(buL + t * BUS + 2 * lane);
                    const float nr = lbr * xr - lbi * xi + bb.x, ni = lbr * xi + lbi * xr + bb.y; xr = nr; xi = ni;
                    *(LAS unsigned*)(XS + t * XSS + 2 * lane) = cvt_pk_bf16(xr, xi);
                    if (sample && (t & 3) == 3) { const size_t si = (((size_t)l * 128 + (b4 * 4 + (t >> 2))) * NG + g) * NP + lane; P->out[O_RES + si] = xr; P->out[O_IMS + si] = xi; }
                }
                asm volatile("s_waitcnt lgkmcnt(0)" ::: "memory");
                f32x4 y = (f32x4){0.f, 0.f, 0.f, 0.f};
#pragma unroll
                for (int ks = 0; ks < 4; ++ks) { const bf16x8 a = *(const LAS bf16x8*)(XS + fr * XSS + fq * 8 + 32 * ks); y = __builtin_amdgcn_mfma_f32_16x16x32_bf16(Cf[ks], a, y, 0, 0, 0); }
                {
                    const int tl = sub * 16 + fr;
                    f32x4 uu;
                    if (!sample) { const u32x2 w = *(const LAS u32x2*)(uT + tl * USB + wave * 16 + 4 * fq); uu = (f32x4){bflo(w.x), bfhi(w.x), bflo(w.y), bfhi(w.y)}; }
                    else { const u32x2 w = *(const u32x2*)(xb + (size_t)(row0 + tl) * D + g * 16 + 4 * fq); const f32x4 gg = *(const f32x4*)(P->in[6] + (l * 6 + 2) * D + g * 16 + 4 * fq);
                        const unsigned a0 = cvt_pk_bf16(bflo(w.x) * gg.x, bfhi(w.x) * gg.y), a1 = cvt_pk_bf16(bflo(w.y) * gg.z, bfhi(w.y) * gg.w);
                        uu = (f32x4){bflo(a0), bfhi(a0), bflo(a1), bfhi(a1)}; }
                    u32x2 o; o.x = cvt_pk_bf16(gelu_tanh(y[0] + dch[0] * uu[0]), gelu_tanh(y[1] + dch[1] * uu[1])); o.y = cvt_pk_bf16(gelu_tanh(y[2] + dch[2] * uu[2]), gelu_tanh(y[3] + dch[3] * uu[3]));
                    *(u32x2*)(GB + (size_t)(row0 + tl) * D + g * 16 + 4 * fq) = o;
                }
                asm volatile("s_waitcnt lgkmcnt(0)" ::: "memory");
            }
        }
        if (!sample && r == 15) { const size_t si = (((size_t)l * 2 + b) * NG + g) * NP + lane; P->out[O_REP + si] = xr; P->out[O_IMP + si] = xi; }
    }
}

constexpr int KST = 72, VST = 264;
__device__ __forceinline__ void phase_attn_prompt(CP P, const int tid, const int bid, const int nblk, int bl, LAS unsigned char* lds) {
    const int lane = tid & 63, wave = tid >> 6, fr = lane & 15, fq = lane >> 4;
    LAS bf16_t* Ks = (LAS bf16_t*)lds;
    LAS bf16_t* Vt = (LAS bf16_t*)(lds + 36864);
    LAS float* bL = (LAS float*)(lds + 36864 + 33792);
    const bf16_t* kvb = (const bf16_t*)(P->ws + W_KVB);
    const bf16_t* Qb = (const bf16_t*)(P->ws + W_QB);
    bf16_t* Ob = (bf16_t*)(P->ws + W_OB);
    const float* biasT = (const float*)(P->ws + W_BIAST);
    for (int unit = bid; unit < 256; unit += nblk) {
        const int kvh = unit & 1, nb = (unit >> 1) & 63, b = unit >> 7;
        __syncthreads();
#pragma unroll
        for (int i = 0; i < 4; ++i) { const int q = tid + NTHREADS * i, key = q >> 3, c8 = q & 7;
            const int pos = (nb - 1) * 128 + key;
            u32x4 kw = (u32x4){0u, 0u, 0u, 0u}, vw = kw;
            if (pos >= 0) { const bf16_t* src = kvb + (size_t)(b * SEQ + pos) * 256 + kvh * 64 + c8 * 8; kw = *(const u32x4*)src; vw = *(const u32x4*)(src + 128); }
            *(LAS u32x4*)(Ks + key * KST + c8 * 8) = kw;
            LAS bf16_t* vd = Vt + (c8 * 8) * VST + key;
            vd[0 * VST] = (bf16_t)(vw.x & 0xffff); vd[1 * VST] = (bf16_t)(vw.x >> 16); vd[2 * VST] = (bf16_t)(vw.y & 0xffff); vd[3 * VST] = (bf16_t)(vw.y >> 16);
            vd[4 * VST] = (bf16_t)(vw.z & 0xffff); vd[5 * VST] = (bf16_t)(vw.z >> 16); vd[6 * VST] = (bf16_t)(vw.w & 0xffff); vd[7 * VST] = (bf16_t)(vw.w >> 16); }
#pragma unroll
        for (int i = 0; i < 2; ++i) { const int q = tid + NTHREADS * i; bL[q] = biasT[(kvh * 8) * 128 + q]; }
        __syncthreads();
        const int qs = wave, t0 = qs < 6 ? qs : 6;
        const int iq = 16 * qs + fr;
        const size_t qrow = (size_t)b * SEQ + nb * 128 + iq;
        bf16x8 q0n = *(const bf16x8*)(Qb + qrow * D + kvh * 512 + fq * 8), q1n = *(const bf16x8*)(Qb + qrow * D + kvh * 512 + 32 + fq * 8);
        for (int hq = 0; hq < 8; ++hq) {
            const int h = kvh * 8 + hq;
            int iql = iq; asm volatile("" : "+v"(iql));
            const int lim = nb > 0 ? 127 : iql;
            const bf16x8 q0 = q0n, q1 = q1n;
            if (hq < 7) { q0n = *(const bf16x8*)(Qb + qrow * D + (h + 1) * 64 + fq * 8); q1n = *(const bf16x8*)(Qb + qrow * D + (h + 1) * 64 + 32 + fq * 8); }
            const float sink = P->in[26][bl * 16 + h];
            f32x4 S[10];
            float mx = -INFINITY;
#pragma unroll
            for (int tt = 0; tt < 10; ++tt) {
                const int key = (t0 + tt) * 16 + fr;
                const bf16x8 k0 = *(const LAS bf16x8*)(Ks + key * KST + fq * 8), k1 = *(const LAS bf16x8*)(Ks + key * KST + 32 + fq * 8);
                f32x4 s = (f32x4){0.f, 0.f, 0.f, 0.f};
                s = __builtin_amdgcn_mfma_f32_16x16x32_bf16(k0, q0, s, 0, 0, 0);
                s = __builtin_amdgcn_mfma_f32_16x16x32_bf16(k1, q1, s, 0, 0, 0);
#pragma unroll
                for (int j = 0; j < 4; ++j) { const int jb = (t0 + tt) * 16 + 4 * fq + j, dist = 128 + iql - jb;
                    const float pen = __int_as_float((((lim - dist) | dist) >> 31) & (int)0xff800000);
                    const float v = s[j] + bL[hq * 128 + (dist & 127)] + pen;
                    s[j] = v; mx = fmaxf(mx, v); }
                S[tt] = s;
            }
            mx = fmaxf(mx, swz_xor(mx, 0x401f)); mx = fmaxf(mx, xor32(mx, lane)); mx = fmaxf(mx, sink);
            float sum = 0.f;
#pragma unroll
            for (int tt = 0; tt < 10; ++tt)
#pragma unroll
                for (int j = 0; j < 4; ++j) { const float p = __expf(S[tt][j] - mx); S[tt][j] = p; sum += p; }
            sum += swz_xor(sum, 0x401f); sum += xor32(sum, lane);
            const float inv = 1.0f / (sum + __expf(sink - mx));
            f32x4 O[4];
#pragma unroll
            for (int dt = 0; dt < 4; ++dt) O[dt] = (f32x4){0.f, 0.f, 0.f, 0.f};
#pragma unroll
            for (int s5 = 0; s5 < 5; ++s5) {
                const f32x4 pa = S[2 * s5] * inv, pb = S[2 * s5 + 1] * inv;
                u32x4 pw; pw.x = cvt_pk_bf16(pa[0], pa[1]); pw.y = cvt_pk_bf16(pa[2], pa[3]); pw.z = cvt_pk_bf16(pb[0], pb[1]); pw.w = cvt_pk_bf16(pb[2], pb[3]);
                const bf16x8 pf = __builtin_bit_cast(bf16x8, pw);
                const int ka = 16 * (t0 + 2 * s5) + 4 * fq, kb = ka + 16;
#pragma unroll
                for (int dt = 0; dt < 4; ++dt) {
                    const LAS bf16_t* vr = Vt + (dt * 16 + fr) * VST;
                    const u32x2 va = *(const LAS u32x2*)(vr + ka), vb = *(const LAS u32x2*)(vr + kb);
                    const u32x4 vw = (u32x4){va.x, va.y, vb.x, vb.y};
                    O[dt] = __builtin_amdgcn_mfma_f32_16x16x32_bf16(__builtin_bit_cast(bf16x8, vw), pf, O[dt], 0, 0, 0);
                }
            }
#pragma unroll
            for (int dt = 0; dt < 4; ++dt) { u32x2 w; w.x = cvt_pk_bf16(O[dt][0], O[dt][1]); w.y = cvt_pk_bf16(O[dt][2], O[dt][3]);
                *(u32x2*)(Ob + qrow * D + h * 64 + dt * 16 + 4 * fq) = w; }
        }
    }
}

__device__ __forceinline__ void phase_attn_sample(CP P, const int tid, const int bid, const int nblk, int bl, LAS unsigned char* lds) {
    const int lane = tid & 63, wave = tid >> 6;
    LAS float* qL = (LAS float*)(lds + 80000 + wave * 4096);
    LAS float* pL = qL + 256;
    const bf16_t* kvb = (const bf16_t*)(P->ws + W_KVB);
    const bf16_t* Qb = (const bf16_t*)(P->ws + W_QB);
    bf16_t* Ob = (bf16_t*)(P->ws + W_OB);
    const float* biasT = (const float*)(P->ws + W_BIAST);
    const int gw = bid * NWAVES + wave, NGW = nblk * NWAVES;
    for (int task = gw; task < 128 * 16; task += NGW) {
        const int h = task & 15, b = task >> 4, kvh = h >> 3;
        const size_t row0 = (size_t)TP + b * 4;
        asm volatile("s_waitcnt lgkmcnt(0)" ::: "memory");
#pragma unroll
        for (int t = 0; t < 4; ++t) qL[t * 64 + lane] = bf2f(Qb[(row0 + t) * D + h * 64 + lane]);
        asm volatile("s_waitcnt lgkmcnt(0)" ::: "memory");
        const float sink = P->in[26][bl * 16 + h];
        float sc[3][4];
#pragma unroll
        for (int r = 0; r < 3; ++r) {
            const int j = lane + 64 * r;
            float a0 = 0.f, a1 = 0.f, a2 = 0.f, a3 = 0.f;
            if (j < 128) {
                const f32x4* kr = (const f32x4*)(P->in[4] + ((size_t)(b * WIN + j) * 2 + kvh) * 64);
#pragma unroll 8
                for (int d4 = 0; d4 < 16; ++d4) { const f32x4 kv = kr[d4];
                    const f32x4 qa = *(const LAS f32x4*)(qL + d4 * 4), qb = *(const LAS f32x4*)(qL + 64 + d4 * 4), qc = *(const LAS f32x4*)(qL + 128 + d4 * 4), qd = *(const LAS f32x4*)(qL + 192 + d4 * 4);
                    a0 += kv.x * qa.x + kv.y * qa.y + kv.z * qa.z + kv.w * qa.w; a1 += kv.x * qb.x + kv.y * qb.y + kv.z * qb.z + kv.w * qb.w;
                    a2 += kv.x * qc.x + kv.y * qc.y + kv.z * qc.z + kv.w * qc.w; a3 += kv.x * qd.x + kv.y * qd.y + kv.z * qd.z + kv.w * qd.w; }
            } else if (j < 132) {
                const u32x2* kr = (const u32x2*)(kvb + (row0 + (j - 128)) * 256 + kvh * 64);
#pragma unroll 4
                for (int d4 = 0; d4 < 16; ++d4) { const u32x2 w = kr[d4]; const f32x4 kv = (f32x4){bflo(w.x), bfhi(w.x), bflo(w.y), bfhi(w.y)};
                    const f32x4 qa = *(const LAS f32x4*)(qL + d4 * 4), qb = *(const LAS f32x4*)(qL + 64 + d4 * 4), qc = *(const LAS f32x4*)(qL + 128 + d4 * 4), qd = *(const LAS f32x4*)(qL + 192 + d4 * 4);
                    a0 += kv.x * qa.x + kv.y * qa.y + kv.z * qa.z + kv.w * qa.w; a1 += kv.x * qb.x + kv.y * qb.y + kv.z * qb.z + kv.w * qb.w;
                    a2 += kv.x * qc.x + kv.y * qc.y + kv.z * qc.z + kv.w * qc.w; a3 += kv.x * qd.x + kv.y * qd.y + kv.z * qd.z + kv.w * qd.w; }
            }
            const float a[4] = {a0, a1, a2, a3};
#pragma unroll
            for (int t = 0; t < 4; ++t) { const int dist = 128 + t - j; const bool valid = j < 132 && dist >= 0 && dist < WIN;
                sc[r][t] = valid ? a[t] + biasT[h * 128 + (dist & 127)] : -INFINITY; }
        }
#pragma unroll
        for (int t = 0; t < 4; ++t) {
            float mx = fmaxf(fmaxf(sc[0][t], sc[1][t]), sc[2][t]); mx = fmaxf(wave_max(mx, lane), sink);
            const float p0 = __expf(sc[0][t] - mx), p1 = __expf(sc[1][t] - mx), p2 = __expf(sc[2][t] - mx);
            const float sum = wave_sum(p0 + p1 + p2, lane);
            const float inv = 1.0f / (sum + __expf(sink - mx));
            pL[t * 136 + lane] = p0 * inv; pL[t * 136 + 64 + lane] = p1 * inv; if (lane < 8) pL[t * 136 + 128 + lane] = p2 * inv;
        }
        asm volatile("s_waitcnt lgkmcnt(0)" ::: "memory");
        float o0 = 0.f, o1 = 0.f, o2 = 0.f, o3 = 0.f;
        const float* vc = P->in[5] + ((size_t)(b * WIN) * 2 + kvh) * 64 + lane;
#pragma unroll 32
        for (int j = 0; j < 128; ++j) { const float v = vc[(size_t)j * 128];
            o0 += pL[j] * v; o1 += pL[136 + j] * v; o2 += pL[272 + j] * v; o3 += pL[408 + j] * v; }
#pragma unroll
        for (int j = 128; j < 132; ++j) { const float v = bf2f(kvb[(row0 + (j - 128)) * 256 + 128 + kvh * 64 + lane]);
            o0 += pL[j] * v; o1 += pL[136 + j] * v; o2 += pL[272 + j] * v; o3 += pL[408 + j] * v; }
        Ob[(row0 + 0) * D + h * 64 + lane] = f2bf(o0); Ob[(row0 + 1) * D + h * 64 + lane] = f2bf(o1);
        Ob[(row0 + 2) * D + h * 64 + lane] = f2bf(o2); Ob[(row0 + 3) * D + h * 64 + lane] = f2bf(o3);
    }
}


#define XB_TMO      128
#define XB_XCNT(j)  (256  + 64 * (j))
#define XB_XSUB(j)  (1280 + 64 * (j))
#define XB_XGEN(j)  (2304 + 64 * (j))
#define XB_TOP      3328
#define XB_TOPGEN   3392
#define XCD_BAR_WORDS 3456
#define XB_SPIN_CAP (1u << 22)
__device__ __forceinline__ unsigned xb_ld(unsigned* p)              { return __hip_atomic_load(p, __ATOMIC_RELAXED, __HIP_MEMORY_SCOPE_AGENT); }
__device__ __forceinline__ unsigned xb_add(unsigned* p, unsigned v) { return __hip_atomic_fetch_add(p, v, __ATOMIC_RELAXED, __HIP_MEMORY_SCOPE_AGENT); }
__device__ __forceinline__ unsigned xb_xcc_id() { return (unsigned)__builtin_amdgcn_s_getreg((3 << 11) | 20) & 0xFu; }
#define XB_SPIN(cond, bar) do { unsigned _sp = 0; while (cond) { __builtin_amdgcn_s_sleep(1); \
    if ((++_sp & 255u) == 0u) { if (xb_ld(&(bar)[XB_TMO])) break; if (_sp > XB_SPIN_CAP) { atomicAdd(&(bar)[XB_TMO], 1u); break; } } } } while (0)
struct XcdBarrier { unsigned* bar; unsigned x; volatile LAS unsigned* st; };
__device__ __forceinline__ XcdBarrier xcd_barrier_post(unsigned* bar, volatile LAS unsigned* st) {
    XcdBarrier b; b.bar = bar; b.x = xb_xcc_id(); b.st = st;
    if (threadIdx.x == 0) (void)xb_add(&bar[XB_XCNT(b.x)], 1u);
    return b;
}
__device__ __forceinline__ void xcd_barrier_complete(unsigned* bar, unsigned x, unsigned& nloc, unsigned& nx) {
    const unsigned G = gridDim.x * gridDim.y * gridDim.z;
    unsigned sum, cnt, mine, sp = 0u;
    for (;;) {
        sum = 0u; cnt = 0u; mine = 0u;
#pragma unroll
        for (unsigned j = 0; j < 16; ++j) { const unsigned c = xb_ld(&bar[XB_XCNT(j)]); sum += c; cnt += (c > 0u) ? 1u : 0u; mine = (j == x) ? c : mine; }
        if (sum == G) break;
        __builtin_amdgcn_s_sleep(1);
        if ((++sp & 255u) == 0u) { if (xb_ld(&bar[XB_TMO])) break; if (sp > XB_SPIN_CAP) { atomicAdd(&bar[XB_TMO], 1u); break; } }
    }
    nloc = mine > 0u ? mine : 1u; nx = cnt > 0u ? cnt : 1u;
}
__device__ __forceinline__ void xcd_barrier(const XcdBarrier& b) {
    asm volatile("s_waitcnt vmcnt(0)" ::: "memory");
    __syncthreads();
    if (threadIdx.x == 0) {
        unsigned* bar = b.bar; asm volatile("" : "+s"(bar));
        __builtin_amdgcn_s_waitcnt(0);
        unsigned nloc = b.st[0], nx = b.st[1];
        if (nloc == 0u) { xcd_barrier_complete(bar, b.x, nloc, nx); b.st[0] = nloc; b.st[1] = nx; }
        const unsigned old = xb_add(&bar[XB_XSUB(b.x)], 1u);
        const unsigned gen = old / nloc;
        if (old + 1u == (gen + 1u) * nloc) {
            __builtin_amdgcn_fence(__ATOMIC_RELEASE, "agent");
            asm volatile("s_waitcnt vmcnt(0)" ::: "memory");
            const unsigned og = xb_add(&bar[XB_TOP], 1u);
            const unsigned tg = og / nx;
            if (og + 1u == (tg + 1u) * nx) xb_add(&bar[XB_TOPGEN], 1u);
            else XB_SPIN(xb_ld(&bar[XB_TOPGEN]) == tg, bar);
            __builtin_amdgcn_fence(__ATOMIC_ACQUIRE, "agent");
            xb_add(&bar[XB_XGEN(b.x)], 1u);
            asm volatile("s_waitcnt vmcnt(0)" ::: "memory");
        } else {
            XB_SPIN(xb_ld(&bar[XB_XGEN(b.x)]) == gen, bar);
            __builtin_amdgcn_fence(__ATOMIC_ACQUIRE, "agent");
            asm volatile("s_waitcnt vmcnt(0)" ::: "memory");
        }
    }
    __syncthreads();
}

__device__ __forceinline__ void run_gemm_gated0(CP P, const int tid, const int bid, const int nblk, LAS unsigned char* lds, const bf16_t* A, const bf16_t* Bt, int N, int K, bf16_t* O, int ldc) {
    pg8::gemm_phase<pg8::EpiGated<0>>(tid, lds, A, Bt, T, N, K, nblk, bid, O, ldc, nullptr, 1.0f, nullptr, 0);
}
__device__ __forceinline__ void run_gemm_gated1(CP P, const int tid, const int bid, const int nblk, LAS unsigned char* lds, const bf16_t* A, const bf16_t* Bt, int N, int K, bf16_t* O, int ldc, const float* bias, int nout) {
    pg8::gemm_phase<pg8::EpiGated<1>>(tid, lds, A, Bt, TP, N, K, nblk, bid, O, ldc, bias, 1.0f, nullptr, nout);
    small_gemm<1>(tid, bid, nblk, lds, A, Bt, N, K, O, ldc, bias, 1.0f, nout);
}
__device__ __forceinline__ void run_gemm_plain(CP P, const int tid, const int bid, const int nblk, LAS unsigned char* lds, const bf16_t* A, const bf16_t* Bt, int N, int K, bf16_t* O, int ldc, const float* bias, float scale) {
    pg8::gemm_phase<pg8::EpiBf16<0>>(tid, lds, A, Bt, TP, N, K, nblk, bid, O, ldc, bias, scale, nullptr, 0);
    small_gemm<0>(tid, bid, nblk, lds, A, Bt, N, K, O, ldc, bias, scale, 0);
}
__device__ __forceinline__ void run_gemm_kv(CP P, const int tid, const int bid, const int nblk, LAS unsigned char* lds) {
    pg8::gemm_phase<pg8::EpiBf16<1>>(tid, lds, (const bf16_t*)(P->ws + W_XB), (const bf16_t*)(P->ws + W_KV), T, 256, D, nblk, (bid + 84) % nblk, (bf16_t*)(P->ws + W_KVB), 256, P->in[23], 1.0f, P->out, 0);
}

__global__ void __launch_bounds__(NTHREADS, 2) mega(Params Pval) {
    extern __shared__ __attribute__((aligned(16))) unsigned char shm[];
    LAS unsigned char* lds = (LAS unsigned char*)shm;
    CP P = launder((CP)__builtin_amdgcn_kernarg_segment_ptr());
    const int ph_lo = P->ph_lo, ph_hi = P->ph_hi;
    volatile LAS unsigned* xst = (volatile LAS unsigned*)(lds + 131072);
    if (threadIdx.x == 0) { xst[0] = 0u; xst[1] = 0u; xst[2] = 0u; xst[3] = 0u; }
    __syncthreads();
    XcdBarrier xb = xcd_barrier_post((unsigned*)(P->ws + W_BAR), xst);
    for (int ph = ph_lo; ph < ph_hi; ++ph) {
    P = launder(P);
    int tid = threadIdx.x, bid = blockIdx.x, nblk = gridDim.x;
    asm volatile("" : "+v"(tid)); const int tid0 = tid; asm volatile("" : "+s"(bid)); asm volatile("" : "+s"(nblk));
    unsigned char* ws = P->ws;
    const bf16_t* XB = (const bf16_t*)(ws + W_XB);
    bf16_t* HB = (bf16_t*)(ws + W_H);
    bf16_t* FB = (bf16_t*)(ws + W_F);
    bf16_t* QB = (bf16_t*)(ws + W_QB);
    bf16_t* OB = (bf16_t*)(ws + W_OB);
    {
        if (ph == 0) { REPLOOP(REP_PRO) phase_prologue(P, tid, bid, nblk, lds); }
        else {
            const int l = (ph - 1) / 10, s = (ph - 1) % 10;
            const float* ng = P->in[6] + (size_t)l * 6 * D;
            if (s == 0 || s == 7) {
                const int f = s == 7;
                if (l == 2 && f == 0) run_gemm_kv(P, tid, bid, nblk, lds);
                REPLOOP(REP_GU)
                run_gemm_gated0(P, tid, bid, nblk, lds, XB, (const bf16_t*)(ws + W_GU) + (size_t)(l * 2 + f) * 2 * FF * D, 2 * FF, D, HB, FF);
                if (l < 2) cvt_in_shadow(P, tid, bid, nblk, lds, l + 1, f);
                else if (l == 2 && f == 1) cvt_in_shadow(P, tid, bid, nblk, lds, 3, 0);
                else if (l == 3 && f == 0) cvt_in_shadow(P, tid, bid, nblk, lds, 3, 1);
            } else if (s == 1 || s == 8) {
                const int f = s == 8;
                REPLOOP(REP_DN)
                run_gemm_plain(P, tid, bid, nblk, lds, HB, (const bf16_t*)(ws + W_DN) + (size_t)(l * 2 + f) * D * FF, D, FF, FB, D, nullptr, 1.0f);
            } else if (s == 2) phase_fixup(P, tid, bid, nblk, 0.5f, ng + 1 * D, false);
            else if (s == 6) phase_fixup(P, tid, bid, nblk, 1.0f, ng + 3 * D, false);
            else if (s == 9) phase_fixup(P, tid, bid, nblk, 0.5f, ng + 5 * D, l == 3);
            else if (s == 3) {
                REPLOOP(REP_MX)
                if (l < 2) phase_ssm_a(P, tid, bid, nblk, l, lds);
                else run_gemm_plain(P, tid, bid, nblk, lds, XB, (const bf16_t*)(ws + W_Q) + (size_t)(l - 2) * D * D, D, D, QB, D, P->in[25] + (l - 2) * D, 0.125f);
            } else if (s == 4) {
                REPLOOP(REP_MX)
                if (l < 2) phase_ssm_b(P, tid, bid, nblk, l, lds);
                else { phase_attn_prompt(P, tid, bid, nblk, l - 2, lds); phase_attn_sample(P, tid, bid, nblk, l - 2, lds); }
            } else if (s == 5) {
                if (l < 2) run_gemm_gated1(P, tid, bid, nblk, lds, QB, (const bf16_t*)(ws + W_GLU) + (size_t)l * 2 * D * D, 2 * D, D, FB, D, P->in[20] + l * 2 * D, D);
                else run_gemm_plain(P, tid, bid, nblk, lds, OB, (const bf16_t*)(ws + W_O) + (size_t)(l - 2) * D * D, D, D, FB, D, P->in[28] + (l - 2) * D, 1.0f);
            }
        }
        if (ph + 1 < ph_hi) { if (ph < 0) cg::this_grid().sync(); else xcd_barrier(xb); }
    }
    }
}

extern "C" void kernel_launch(void* const* d_in, const int* in_sizes, int n_in, void* d_out, int out_size, void* d_ws, size_t ws_size, hipStream_t stream) {
    static int grid = 0;
    if (grid == 0) {
        if (n_in != 30 || (size_t)out_size != O_END || ws_size < W_END) { fprintf(stderr, "kernel_launch: unexpected shapes n_in %d out %d ws %zu (need %zu)\n", n_in, out_size, ws_size, (size_t)W_END); grid = -1; return; }
        int dev = 0, cus = 0, per_cu = 0;
        hipGetDevice(&dev);
        hipDeviceGetAttribute(&cus, hipDeviceAttributeMultiprocessorCount, dev);
        if (hipFuncSetAttribute((const void*)mega, hipFuncAttributeMaxDynamicSharedMemorySize, LDS_BYTES) != hipSuccess) { fprintf(stderr, "kernel_launch: hipFuncSetAttribute failed\n"); grid = -1; return; }
        hipOccupancyMaxActiveBlocksPerMultiprocessor(&per_cu, (const void*)mega, NTHREADS, LDS_BYTES);
        if (per_cu < 1) { fprintf(stderr, "kernel_launch: occupancy query says %d blocks per CU\n", per_cu); per_cu = 1; }
        (void)hipGetLastError();
        grid = cus * 1;
    }
    if (grid < 0) return;
    if (hipMemsetAsync((char*)d_ws + W_BAR, 0, 3456 * 4, stream) != hipSuccess) { fprintf(stderr, "kernel_launch: memset failed\n"); return; }
    Params p{};
    for (int i = 0; i < 30; ++i) p.in[i] = (const float*)d_in[i];
    p.out = (float*)d_out; p.ws = (unsigned char*)d_ws;
#if MK_MULTI
    for (int ph = 0; ph < NPHASES; ++ph) { p.ph_lo = ph; p.ph_hi = ph + 1; hipLaunchKernelGGL(mega, dim3(grid), dim3(NTHREADS), LDS_BYTES, stream, p); }
#else
    p.ph_lo = 0; p.ph_hi = NPHASES;
    void* args[] = {&p};
    hipError_t e = hipLaunchCooperativeKernel((const void*)mega, dim3(grid), dim3(NTHREADS), args, LDS_BYTES, stream);
    if (e != hipSuccess) fprintf(stderr, "cooperative launch failed: %s (grid %d)\n", hipGetErrorString(e), grid);
#endif
}
```

```cpp
#include <hip/hip_runtime.h>
#include <hip/hip_cooperative_groups.h>
#include <cstdio>
namespace cg = cooperative_groups;

#ifndef MK_MULTI
#define MK_MULTI 0
#endif

#ifndef REP_PRO
#define REP_PRO 1
#define REP_GU 1
#define REP_DN 1
#define REP_MX 1
#define REP_FX 1
#endif
#define REPLOOP(n) for (int rep = 0, tid = tid0; rep < (n); ++rep, ({ asm volatile("" : "+v"(tid)); }))
#define LAS __attribute__((address_space(3)))
typedef unsigned short bf16_t;
typedef short bf16x8 __attribute__((ext_vector_type(8)));
typedef short bf16x4 __attribute__((ext_vector_type(4)));
typedef float f32x4 __attribute__((ext_vector_type(4)));
typedef float f32x2 __attribute__((ext_vector_type(2)));
typedef unsigned u32x4 __attribute__((ext_vector_type(4)));
typedef unsigned u32x2 __attribute__((ext_vector_type(2)));

constexpr int D = 1024, FF = 2816, TP = 16384, TS = 512, T = TP + TS, SEQ = 8192;
constexpr int NG = 64, NP = 64, GS = 16;
constexpr int WIN = 128;
constexpr float RMS_EPS = 1e-6f;
constexpr int NTHREADS = 512, NWAVES = 8;
constexpr int LDS_BYTES = 131072 + 16;
constexpr int NPHASES = 41;

constexpr size_t O_Y = 0;
constexpr size_t O_REP = (size_t)T * D;
constexpr size_t O_IMP = O_REP + 16384;
constexpr size_t O_KP = O_IMP + 16384;
constexpr size_t O_VP = O_KP + 32768;
constexpr size_t O_RES = O_VP + 32768;
constexpr size_t O_IMS = O_RES + 1048576;
constexpr size_t O_KS = O_IMS + 1048576;
constexpr size_t O_VS = O_KS + 2097152;
constexpr size_t O_END = O_VS + 2097152;

constexpr size_t W_GU = 0;
constexpr size_t W_DN = W_GU + (size_t)8 * 5632 * 1024 * 2;
constexpr size_t W_GLU = W_DN + (size_t)8 * 1024 * 2816 * 2;
constexpr size_t W_Q = W_GLU + (size_t)2 * 2048 * 1024 * 2;
constexpr size_t W_O = W_Q + (size_t)2 * 1024 * 1024 * 2;
constexpr size_t W_KV = W_O + (size_t)2 * 1024 * 1024 * 2;
constexpr size_t W_XB = W_KV + (size_t)256 * 1024 * 2;
constexpr size_t W_H = W_XB + (size_t)T * D * 2;
constexpr size_t W_QB = W_H;
constexpr size_t W_OB = W_H + (size_t)T * D * 2;
constexpr size_t W_F = W_H + (size_t)T * FF * 2;
constexpr size_t W_KVB = W_F + (size_t)T * D * 2;
constexpr size_t W_SFIN = W_KVB + (size_t)T * 256 * 2;
constexpr size_t W_BIAST = W_SFIN + (size_t)2 * 128 * 64 * 64 * 8;
constexpr size_t W_INVR = W_BIAST + 16 * 128 * 4;
constexpr size_t W_BAR = W_INVR + (size_t)T * 4 + 1024;
constexpr size_t W_END = W_BAR + 3456 * 4;

struct Params {
    const float* in[30];
    float* out;
    unsigned char* ws;
    int ph_lo, ph_hi;
};
typedef __attribute__((address_space(4))) const Params* CP;
__device__ __forceinline__ CP launder(CP p) { asm volatile("" : "+s"(p)); return p; }

__device__ __forceinline__ unsigned cvt_pk_bf16(float lo, float hi) { unsigned r; asm volatile("v_cvt_pk_bf16_f32 %0, %1, %2" : "=v"(r) : "v"(lo), "v"(hi)); return r; }
__device__ __forceinline__ bf16_t f2bf(float f) { return (bf16_t)(cvt_pk_bf16(f, 0.f) & 0xffffu); }
__device__ __forceinline__ float bf2f(unsigned b) { return __uint_as_float(b << 16); }
__device__ __forceinline__ float bflo(unsigned w) { return __uint_as_float(w << 16); }
__device__ __forceinline__ float bfhi(unsigned w) { return __uint_as_float(w & 0xffff0000u); }
#define swz_xor(v, pat) __int_as_float(__builtin_amdgcn_ds_swizzle(__float_as_int(v), (pat)))
__device__ __forceinline__ float xor32(float v, int lane) { return __int_as_float(__builtin_amdgcn_ds_bpermute((lane ^ 32) << 2, __float_as_int(v))); }
__device__ __forceinline__ float wave_sum(float v, int lane) {
    v += swz_xor(v, 0x041f); v += swz_xor(v, 0x081f); v += swz_xor(v, 0x101f); v += swz_xor(v, 0x201f); v += swz_xor(v, 0x401f);
    return v + xor32(v, lane);
}
__device__ __forceinline__ float wave_max(float v, int lane) {
    v = fmaxf(v, swz_xor(v, 0x041f)); v = fmaxf(v, swz_xor(v, 0x081f)); v = fmaxf(v, swz_xor(v, 0x101f)); v = fmaxf(v, swz_xor(v, 0x201f)); v = fmaxf(v, swz_xor(v, 0x401f));
    return fmaxf(v, xor32(v, lane));
}
__device__ __forceinline__ float fast_sigmoid(float x) { return __builtin_amdgcn_rcpf(1.0f + __expf(-x)); }

namespace pg8 {
constexpr int BM = 256, BK = 64, HALF = 128, HTB = HALF * BK * 2, STAGE_BYTES = 8 * HTB, NXCD = 8, WGM = 8;
__device__ __forceinline__ int lds_byte(int r, int c) { const int st = (r >> 4) * 2 + (c >> 5), rr = r & 15, cc = c & 31, ob = rr * 64 + cc * 2; return st * 1024 + (ob ^ (((ob >> 9) & 1) << 5)); }
__device__ __forceinline__ void stage_rc(int b, int& R, int& C) { const int st = b / 1024, sb = b % 1024, swz = sb ^ (((sb >> 9) & 1) << 5); R = (st >> 1) * 16 + swz / 64; C = (st & 1) * 32 + (swz % 64) / 2; }
__device__ __forceinline__ int perm32(int rho) { const int n = rho >> 4, i = rho & 15; return 8 * (i >> 2) + 4 * n + (i & 3); }

struct Unit { int pm, pn; };

struct StaticOrder {
    int nM, nN, nwg, G, c, wgm;
    __device__ void init(int M, int N, int G_, int c_) { nM = M / BM; nN = N / BM; nwg = nM * nN; G = G_; c = c_; wgm = nN > 8 ? 4 : WGM; }
    __device__ bool next(int i, Unit& u) const {
        const long L = (long)i * G + c; if (L >= nwg) return false;
        int wgid = (int)L; { const int q = nwg / NXCD, r = nwg % NXCD, xcd = wgid % NXCD, off = wgid / NXCD; wgid = (xcd < r ? xcd * (q + 1) : r * (q + 1) + (xcd - r) * q) + off; }
        const int nig = wgm * nN, gid = wgid / nig, fm = gid * wgm, gsz = (nM - fm) < wgm ? (nM - fm) : wgm;
        u.pm = fm + ((wgid % nig) % gsz); u.pn = (wgid % nig) / gsz; return true;
    }
};

template <class Epi>
__device__ __forceinline__ void gemm_phase(const int tid, LAS unsigned char* lds, const bf16_t* gA, const bf16_t* gBt, const int gM, const int gN, const int gK, const int gridn, const int cidx,
                                           bf16_t* eO, const int eldc, const float* ebias, const float escale, float* eout, const int enout) {
    StaticOrder S; S.init(gM, gN, gridn, cidx);
    struct { const bf16_t* A; const bf16_t* Bt; int K; } g{gA, gBt, gK};
    const int wid = __builtin_amdgcn_readfirstlane(tid >> 6), lane = tid & 63, wr = wid >> 2, wc = wid & 3, fr = lane & 15, fq = lane >> 4;
    const int K = g.K, nt = K / BK;
    unsigned voffA[2], voffB[2];
#pragma unroll
    for (int i = 0; i < 2; ++i) { int R, C; stage_rc(tid * 16 + i * 8192, R, C); const int Rb = Epi::PERM ? ((R & ~31) + perm32(R & 31)) : R;
        voffA[i] = (unsigned)(R * K + C) * 2u; voffB[i] = (unsigned)(Rb * K + C) * 2u; }
    const size_t kstep = (size_t)(BK * 2);
    const size_t hstep = (size_t)HALF * K * 2;
    const size_t tstep = 2 * hstep;
    const unsigned ldsw = (unsigned)wid * 1024u;
    const int aoff = lds_byte(wr * 64 + fr, fq * 8), boff = lds_byte(wc * 32 + fr, fq * 8);
#define PG8_SA(b, h) (((b) * 2 + (h)) * HTB)
#define PG8_SB(b, h) ((4 + (b) * 2 + (h)) * HTB)
#define PG8_STAGE(bufoff, gbase, voff) do { _Pragma("unroll") for (int _i = 0; _i < 2; ++_i) \
        __builtin_amdgcn_global_load_lds((const unsigned*)((const char*)(gbase) + (voff)[_i]), (LAS unsigned*)(lds + (bufoff) + ldsw + _i * 8192), 16, 0, 0); } while (0)
#define PG8_LDA(dst, b, h) do { _Pragma("unroll") for (int m = 0; m < 4; ++m) _Pragma("unroll") for (int k = 0; k < 2; ++k) dst[m][k] = *(const LAS bf16x8*)(lds + PG8_SA(b, h) + aoff + m * 2048 + k * 1024); } while (0)
#define PG8_LDB(dst, b, h) do { _Pragma("unroll") for (int n = 0; n < 2; ++n) _Pragma("unroll") for (int k = 0; k < 2; ++k) dst[n][k] = *(const LAS bf16x8*)(lds + PG8_SB(b, h) + boff + n * 2048 + k * 1024); } while (0)
#define PG8_MMA(ai, bj, At, Bt) do { __builtin_amdgcn_s_setprio(1); _Pragma("unroll") for (int m = 0; m < 4; ++m) _Pragma("unroll") for (int n = 0; n < 2; ++n) _Pragma("unroll") for (int k = 0; k < 2; ++k) \
        acc[ai][bj][m][n] = __builtin_amdgcn_mfma_f32_16x16x32_bf16(Bt[n][k], At[m][k], acc[ai][bj][m][n], 0, 0, 0); __builtin_amdgcn_s_setprio(0); } while (0)
#define PG8_WAIT_V(n) asm volatile("s_waitcnt vmcnt(" #n ")" ::: "memory")
#define PG8_WAIT_L(n) asm volatile("s_waitcnt lgkmcnt(" #n ")" ::: "memory")
#define PG8_BAR __builtin_amdgcn_s_barrier()
#define PG8_SCHED __builtin_amdgcn_sched_barrier(0)
    Unit cur, nxt; int ui = 0;
    if (!S.next(0, cur)) return;
    f32x4 acc[2][2][4][2];
#pragma unroll
    for (int a = 0; a < 2; ++a)
#pragma unroll
        for (int b = 0; b < 2; ++b)
#pragma unroll
            for (int m = 0; m < 4; ++m)
#pragma unroll
                for (int n = 0; n < 2; ++n) acc[a][b][m][n] = (f32x4){0.f, 0.f, 0.f, 0.f};
    bf16x8 At[4][2], B0[2][2], B1[2][2];
    const char* cA = (const char*)g.A + (size_t)cur.pm * tstep; const char* cB = (const char*)g.Bt + (size_t)cur.pn * tstep;
    PG8_STAGE(PG8_SB(0, 0), cB, voffB); PG8_STAGE(PG8_SA(0, 0), cA, voffA); PG8_STAGE(PG8_SB(0, 1), cB + hstep, voffB); PG8_STAGE(PG8_SA(0, 1), cA + hstep, voffA);
    if (wr == 1) PG8_BAR;
    PG8_WAIT_V(4); PG8_BAR;
    PG8_STAGE(PG8_SB(1, 0), cB + kstep, voffB); PG8_STAGE(PG8_SA(1, 0), cA + kstep, voffA); PG8_STAGE(PG8_SB(1, 1), cB + hstep + kstep, voffB);
    PG8_WAIT_V(6); PG8_BAR;
    for (;;) {
        const bool has_next = S.next(ui + 1, nxt);
        const char* nA = has_next ? (const char*)g.A + (size_t)nxt.pm * tstep : cA; const char* nB = has_next ? (const char*)g.Bt + (size_t)nxt.pn * tstep : cB;
        for (int t = 0; t < nt; t += 2) {
            const bool last = (t == nt - 2);
            const char* a1 = cA + (size_t)(t + 1) * kstep;
            const char* a2 = last ? nA : cA + (size_t)(t + 2) * kstep; const char* b2 = last ? nB : cB + (size_t)(t + 2) * kstep;
            const char* a3 = a2 + kstep; const char* b3 = b2 + kstep;
            PG8_LDB(B0, 0, 0); PG8_SCHED; PG8_LDA(At, 0, 0); PG8_STAGE(PG8_SA(1, 1), a1 + hstep, voffA);
            PG8_WAIT_L(8); PG8_BAR; PG8_WAIT_L(0); PG8_MMA(0, 0, At, B0); PG8_BAR; PG8_SCHED;
            PG8_LDB(B1, 0, 1); PG8_STAGE(PG8_SB(0, 0), b2, voffB);
            PG8_BAR; PG8_WAIT_L(0); PG8_MMA(0, 1, At, B1); PG8_BAR;
            PG8_LDA(At, 0, 1); PG8_STAGE(PG8_SA(0, 0), a2, voffA);
            PG8_BAR; PG8_WAIT_L(0); PG8_MMA(1, 0, At, B0); PG8_BAR; PG8_SCHED;
            PG8_STAGE(PG8_SB(0, 1), b2 + hstep, voffB);
            PG8_WAIT_V(6); PG8_BAR; PG8_MMA(1, 1, At, B1); PG8_BAR;
            PG8_LDB(B0, 1, 0); PG8_SCHED; PG8_LDA(At, 1, 0); PG8_STAGE(PG8_SA(0, 1), a2 + hstep, voffA);
            PG8_WAIT_L(8); PG8_BAR; PG8_WAIT_L(0); PG8_MMA(0, 0, At, B0); PG8_BAR; PG8_SCHED;
            PG8_LDB(B1, 1, 1); PG8_STAGE(PG8_SB(1, 0), b3, voffB);
            PG8_BAR; PG8_WAIT_L(0); PG8_MMA(0, 1, At, B1); PG8_BAR;
            PG8_LDA(At, 1, 1); PG8_STAGE(PG8_SA(1, 0), a3, voffA);
            PG8_BAR; PG8_WAIT_L(0); PG8_MMA(1, 0, At, B0); PG8_BAR; PG8_SCHED;
            PG8_STAGE(PG8_SB(1, 1), b3 + hstep, voffB);
            PG8_WAIT_V(6); PG8_BAR; PG8_MMA(1, 1, At, B1); PG8_BAR;
        }
        Epi::run(acc, cur, wr, wc, fr, fq, eO, eldc, ebias, escale, eout, enout);
        if (!has_next) break;
#pragma unroll
        for (int a = 0; a < 2; ++a)
#pragma unroll
            for (int b = 0; b < 2; ++b)
#pragma unroll
                for (int m = 0; m < 4; ++m)
#pragma unroll
                    for (int n = 0; n < 2; ++n) acc[a][b][m][n] = (f32x4){0.f, 0.f, 0.f, 0.f};
        cur = nxt; cA = nA; cB = nB; ++ui;
    }
    PG8_WAIT_V(0);
    if (wr == 0) PG8_BAR;
    PG8_BAR;
#undef PG8_SA
#undef PG8_SB
#undef PG8_STAGE
#undef PG8_LDA
#undef PG8_LDB
#undef PG8_MMA
#undef PG8_WAIT_V
#undef PG8_WAIT_L
#undef PG8_BAR
#undef PG8_SCHED
}

template <int MODE> struct EpiGated {
    static constexpr bool PERM = true;
    static __device__ __forceinline__ void run(const f32x4 (&acc)[2][2][4][2], const Unit& u, int wr, int wc, int fr, int fq, bf16_t* O, int ldc, const float* bias, float scale, float* out, int nout) {
        const int row0 = u.pm * BM + wr * 64 + fr, col0 = u.pn * HALF + wc * 32 + 8 * fq;
        f32x4 ba[2], bb[2];
        if (MODE == 1) {
#pragma unroll
            for (int n = 0; n < 2; ++n) { ba[n] = *(const f32x4*)(bias + col0 + 4 * n); bb[n] = *(const f32x4*)(bias + nout + col0 + 4 * n); }
        }
#pragma unroll
        for (int ai = 0; ai < 2; ++ai)
#pragma unroll
            for (int m = 0; m < 4; ++m) {
                bf16_t* rowp = O + (size_t)(row0 + ai * HALF + m * 16) * ldc + col0;
                float o[8];
                if (MODE == 0) {
#pragma unroll
                    for (int n = 0; n < 2; ++n)
#pragma unroll
                        for (int h = 0; h < 2; ++h) {
                            const f32x2 a = (f32x2){acc[ai][0][m][n][2 * h], acc[ai][0][m][n][2 * h + 1]}, b = (f32x2){acc[ai][1][m][n][2 * h], acc[ai][1][m][n][2 * h + 1]};
                            const f32x2 t = a * (-1.4426950408889634f);
                            f32x2 e; e.x = __builtin_amdgcn_exp2f(t.x); e.y = __builtin_amdgcn_exp2f(t.y);
                            const f32x2 d = e + 1.0f;
                            f32x2 r; r.x = __builtin_amdgcn_rcpf(d.x); r.y = __builtin_amdgcn_rcpf(d.y);
                            const f32x2 v = (a * b) * r;
                            o[4 * n + 2 * h] = v.x; o[4 * n + 2 * h + 1] = v.y;
                        }
                } else {
#pragma unroll
                    for (int n = 0; n < 2; ++n)
#pragma unroll
                        for (int j = 0; j < 4; ++j) { const float a = acc[ai][0][m][n][j], b = acc[ai][1][m][n][j]; o[4 * n + j] = (a + ba[n][j]) * fast_sigmoid(b + bb[n][j]); }
                }
                u32x4 w; w.x = cvt_pk_bf16(o[0], o[1]); w.y = cvt_pk_bf16(o[2], o[3]); w.z = cvt_pk_bf16(o[4], o[5]); w.w = cvt_pk_bf16(o[6], o[7]);
                *(u32x4*)rowp = w;
            }
    }
};
template <int KV> struct EpiBf16 {
    static constexpr bool PERM = true;
    static __device__ __forceinline__ void run(const f32x4 (&acc)[2][2][4][2], const Unit& u, int wr, int wc, int fr, int fq, bf16_t* O, int ldc, const float* bias, float scale, float* out, int nout) {
        const int row0 = u.pm * BM + wr * 64 + fr, col0 = u.pn * BM + wc * 32 + 8 * fq;
        f32x4 bv[2][2];
#pragma unroll
        for (int bj = 0; bj < 2; ++bj)
#pragma unroll
            for (int n = 0; n < 2; ++n) bv[bj][n] = bias ? *(const f32x4*)(bias + col0 + bj * HALF + 4 * n) : (f32x4){0.f, 0.f, 0.f, 0.f};
#pragma unroll
        for (int ai = 0; ai < 2; ++ai)
#pragma unroll
            for (int m = 0; m < 4; ++m) {
                const int row = row0 + ai * HALF + m * 16;
                bf16_t* rowp = O + (size_t)row * ldc + col0;
                float* wrow = nullptr;
                size_t vdelta = 0;
                if (KV) {
                    if (row < TP) { const int b = row >> 13, s = row & (SEQ - 1); if (s >= SEQ - WIN) { wrow = out + O_KP + ((size_t)b * WIN + (s - (SEQ - WIN))) * 128; vdelta = O_VP - O_KP; } }
                    else { const int rr = row - TP, b = rr >> 2, t = rr & 3; wrow = out + O_KS + ((size_t)b * WIN + (WIN - 4 + t)) * 128; vdelta = O_VS - O_KS; }
                }
#pragma unroll
                for (int bj = 0; bj < 2; ++bj) {
                    const f32x4 v0 = (acc[ai][bj][m][0] + bv[bj][0]) * scale, v1 = (acc[ai][bj][m][1] + bv[bj][1]) * scale;
                    u32x4 w; w.x = cvt_pk_bf16(v0[0], v0[1]); w.y = cvt_pk_bf16(v0[2], v0[3]); w.z = cvt_pk_bf16(v1[0], v1[1]); w.w = cvt_pk_bf16(v1[2], v1[3]);
                    *(u32x4*)(rowp + bj * HALF) = w;
                    if (KV) { if (wrow) { float* dst = wrow + (bj ? vdelta : 0) + (col0 & 127);
                        *(f32x4*)dst = v0; *(f32x4*)(dst + 4) = v1; } }
                }
            }
    }
};
}


constexpr int SGS = 68;
template <int GATED>
__device__ __forceinline__ void small_gemm(const int tid, const int bid, const int nblk, LAS unsigned char* lds, const bf16_t* A, const bf16_t* Bt, const int N, const int K,
                                           bf16_t* O, const int ldc, const float* bias, const float scale, const int nout) {
    const int lane = tid & 63, wave = __builtin_amdgcn_readfirstlane(tid >> 6), fr = lane & 15, fq = lane >> 4;
    LAS float* part = (LAS float*)lds;
    const int ncol = GATED ? nout / 32 : N / 64, nunits = (TS / 32) * ncol;
    const int kw = K / 8, nks = kw / 32;
    for (int unit = bid; unit < nunits; unit += nblk) {
        const int rt = unit / ncol, ct = unit % ncol;
        const int r0 = TP + rt * 32;
        int brow[4];
#pragma unroll
        for (int f = 0; f < 4; ++f) {
            if (GATED) { const int oc0 = ct * 32, base = (oc0 >> 7) * 256 + (oc0 & 127); brow[f] = base + (f >> 1) * 128 + (f & 1) * 16 + fr; }
            else brow[f] = ct * 64 + f * 16 + fr;
        }
        const bf16_t* ap0 = A + (size_t)(r0 + fr) * K + wave * kw + fq * 8;
        const bf16_t* ap1 = ap0 + (size_t)16 * K;
        const bf16_t* bp[4];
#pragma unroll
        for (int f = 0; f < 4; ++f) bp[f] = Bt + (size_t)brow[f] * K + wave * kw + fq * 8;
        f32x4 acc[2][4];
#pragma unroll
        for (int i = 0; i < 2; ++i)
#pragma unroll
            for (int f = 0; f < 4; ++f) acc[i][f] = (f32x4){0.f, 0.f, 0.f, 0.f};
        bf16x8 pa0[2], pa1[2], pb[2][4], qa0[2], qa1[2], qb[2][4];
#define SG_LOAD(A0, A1, B, KS) do { _Pragma("unroll") for (int u = 0; u < 2; ++u) if ((KS) + u < nks) { const int ko = ((KS) + u) * 32; \
            A0[u] = *(const bf16x8*)(ap0 + ko); A1[u] = *(const bf16x8*)(ap1 + ko); _Pragma("unroll") for (int f = 0; f < 4; ++f) B[u][f] = *(const bf16x8*)(bp[f] + ko); } } while (0)
#define SG_MMA(A0, A1, B, KS) do { _Pragma("unroll") for (int u = 0; u < 2; ++u) if ((KS) + u < nks) { _Pragma("unroll") for (int f = 0; f < 4; ++f) { \
            acc[0][f] = __builtin_amdgcn_mfma_f32_16x16x32_bf16(A0[u], B[u][f], acc[0][f], 0, 0, 0); acc[1][f] = __builtin_amdgcn_mfma_f32_16x16x32_bf16(A1[u], B[u][f], acc[1][f], 0, 0, 0); } } } while (0)
        SG_LOAD(pa0, pa1, pb, 0);
        for (int ks0 = 0; ks0 < nks; ks0 += 4) {
            if (ks0 + 2 < nks) SG_LOAD(qa0, qa1, qb, ks0 + 2);
            SG_MMA(pa0, pa1, pb, ks0);
            if (ks0 + 4 < nks) SG_LOAD(pa0, pa1, pb, ks0 + 4);
            if (ks0 + 2 < nks) SG_MMA(qa0, qa1, qb, ks0 + 2);
        }
#undef SG_LOAD
#undef SG_MMA
        __syncthreads();
#pragma unroll
        for (int i = 0; i < 2; ++i)
#pragma unroll
            for (int f = 0; f < 4; ++f)
#pragma unroll
                for (int j = 0; j < 4; ++j) part[(wave * 32 + 16 * i + 4 * fq + j) * SGS + 16 * f + fr] = acc[i][f][j];
        __syncthreads();
        const int row = tid >> 4, c4 = (tid & 15) * 4;
        f32x4 sum = (f32x4){0.f, 0.f, 0.f, 0.f};
#pragma unroll
        for (int w = 0; w < 8; ++w) sum += *(const LAS f32x4*)(part + (w * 32 + row) * SGS + c4);
        if (!GATED) {
            const int col = ct * 64 + c4;
            f32x4 bv = bias ? *(const f32x4*)(bias + col) : (f32x4){0.f, 0.f, 0.f, 0.f};
            const f32x4 v = (sum + bv) * scale;
            u32x2 w; w.x = cvt_pk_bf16(v[0], v[1]); w.y = cvt_pk_bf16(v[2], v[3]);
            *(u32x2*)(O + (size_t)(r0 + row) * ldc + col) = w;
        } else {
            if (c4 < 32) {
                f32x4 sb = (f32x4){0.f, 0.f, 0.f, 0.f};
#pragma unroll
                for (int w = 0; w < 8; ++w) sb += *(const LAS f32x4*)(part + (w * 32 + row) * SGS + 32 + c4);
                const int col = ct * 32 + c4;
                const f32x4 ba = *(const f32x4*)(bias + col), bb = *(const f32x4*)(bias + nout + col);
                float o[4];
#pragma unroll
                for (int j = 0; j < 4; ++j) o[j] = (sum[j] + ba[j]) * fast_sigmoid(sb[j] + bb[j]);
                u32x2 w; w.x = cvt_pk_bf16(o[0], o[1]); w.y = cvt_pk_bf16(o[2], o[3]);
                *(u32x2*)(O + (size_t)(r0 + row) * ldc + col) = w;
            }
        }
    }
    __syncthreads();
}

constexpr int CTS = 266;
__device__ __forceinline__ void cvt_block_item(const float* W, int K, int Nsrc, bf16_t* WT, int Ndst, int inter, int halfoff, const float* gk, LAS unsigned char* lds, int item, int tid) {
    const int lane = tid & 63, wave = __builtin_amdgcn_readfirstlane(tid >> 6);
    const int nb256 = Ndst / 256, kb = item / nb256, nb = item % nb256, k0 = 64 * kb, r0 = 256 * nb;
    LAS unsigned* Tl = (LAS unsigned*)lds;
    const int r = r0 + 4 * lane, c = inter ? ((r >> 8) * 128 + (r & 127) + ((r >> 7) & 1) * halfoff) : r;
    const float* src = W + (size_t)(k0 + wave * 8) * Nsrc + c;
    f32x4 v[8];
#pragma unroll
    for (int i = 0; i < 8; ++i) v[i] = *(const f32x4*)(src + (size_t)i * Nsrc);
#pragma unroll
    for (int i = 0; i < 8; ++i) { const float gs = gk ? gk[k0 + wave * 8 + i] : 1.0f;
        LAS unsigned* d = Tl + (wave * 8 + i) * (CTS / 2) + 2 * lane;
        d[0] = cvt_pk_bf16(v[i].x * gs, v[i].y * gs); d[1] = cvt_pk_bf16(v[i].z * gs, v[i].w * gs); }
    __syncthreads();
    const LAS bf16_t* Tb = (const LAS bf16_t*)lds;
    const int ch = tid & 7;
#pragma unroll
    for (int i = 0; i < 4; ++i) { const int n = i * 64 + (tid >> 3); const LAS bf16_t* t = Tb + (ch * 8) * CTS + n;
        u32x4 o;
        o.x = (unsigned)t[0 * CTS] | ((unsigned)t[1 * CTS] << 16); o.y = (unsigned)t[2 * CTS] | ((unsigned)t[3 * CTS] << 16);
        o.z = (unsigned)t[4 * CTS] | ((unsigned)t[5 * CTS] << 16); o.w = (unsigned)t[6 * CTS] | ((unsigned)t[7 * CTS] << 16);
        *(u32x4*)(WT + (size_t)(r0 + n) * K + k0 + ch * 8) = o; }
    __syncthreads();
}

__device__ __forceinline__ int t5_bucket(int n) {
    if (n < 16) return n;
    int large = 16 + (int)(logf((float)n / 16.0f) / 2.0794415416798357f * 16.0f);
    return large < 31 ? large : 31;
}

__device__ __forceinline__ void store_xhat(const f32x4 (&v)[4], bf16_t* xbrow, float* invr, int lane) {
    float s = 0.f;
#pragma unroll
    for (int j = 0; j < 4; ++j) s += (v[j].x * v[j].x + v[j].y * v[j].y) + (v[j].z * v[j].z + v[j].w * v[j].w);
    const float ms = wave_sum(s, lane) * (1.0f / D) + RMS_EPS;
    const float rstd = rsqrtf(ms);
    if (lane == 0) *invr = sqrtf(ms);
    u32x2* o8 = (u32x2*)xbrow + lane;
#pragma unroll
    for (int j = 0; j < 4; ++j) { u32x2 w; w.x = cvt_pk_bf16(v[j].x * rstd, v[j].y * rstd); w.y = cvt_pk_bf16(v[j].z * rstd, v[j].w * rstd); o8[64 * j] = w; }
}

__device__ __forceinline__ void cvt_layer(CP P, const int tid, LAS unsigned char* lds, const int layer, const int half, const int widx, const int nw) {
    unsigned char* ws = P->ws;
    int base = 0;
    for (int job = 0; job < 23; ++job) {
        const float* src; int K, Nsrc, Ndst, inter = 0, halfoff = 0, jl, jh; bf16_t* dst; const float* gk = nullptr;
        if (job < 8) { const int l = job >> 1, f = job & 1; jl = l; jh = f; src = P->in[f ? 9 : 7] + (size_t)l * D * 2 * FF; K = D; Nsrc = 2 * FF; Ndst = 2 * FF; inter = 1; halfoff = FF;
            dst = (bf16_t*)(ws + W_GU) + (size_t)job * 2 * FF * D; gk = P->in[6] + (l * 6 + (f ? 4 : 0)) * D; }
        else if (job < 16) { const int j = job - 8, l = j >> 1, f = j & 1; jl = l; jh = f; src = P->in[f ? 10 : 8] + (size_t)l * FF * D; K = FF; Nsrc = D; Ndst = D; dst = (bf16_t*)(ws + W_DN) + (size_t)j * D * FF; }
        else if (job < 18) { const int l = job - 16; jl = l; jh = 0; src = P->in[19] + (size_t)l * D * 2 * D; K = D; Nsrc = 2 * D; Ndst = 2 * D; inter = 1; halfoff = D; dst = (bf16_t*)(ws + W_GLU) + (size_t)l * 2 * D * D; }
        else if (job < 20) { const int bl = job - 18; jl = 2 + bl; jh = 0; src = P->in[24] + (size_t)bl * D * D; K = D; Nsrc = D; Ndst = D; dst = (bf16_t*)(ws + W_Q) + (size_t)bl * D * D; gk = P->in[6] + ((2 + bl) * 6 + 2) * D; }
        else if (job < 22) { const int bl = job - 20; jl = 2 + bl; jh = 0; src = P->in[27] + (size_t)bl * D * D; K = D; Nsrc = D; Ndst = D; dst = (bf16_t*)(ws + W_O) + (size_t)bl * D * D; }
        else { jl = 2; jh = 1; src = P->in[22]; K = D; Nsrc = 256; Ndst = 256; dst = (bf16_t*)(ws + W_KV); gk = P->in[21]; }
        if (jl != layer || (half >= 0 && jh != half)) continue;
        const int nitems = (K / 64) * (Ndst / 256);
        int first = (widx - base) % nw; if (first < 0) first += nw;
        for (int it = first; it < nitems; it += nw) cvt_block_item(src, K, Nsrc, dst, Ndst, inter, halfoff, gk, lds, it, tid);
        base += nitems;
    }
}
__device__ __forceinline__ void cvt_in_shadow(CP P, const int tid, const int bid, const int nblk, LAS unsigned char* lds, const int layer, const int half) {
    const int rem = (66 * 22) % nblk, lo = rem ? rem : 0;
    if (bid < lo) return;
    cvt_layer(P, tid, lds, layer, half, bid - lo, nblk - lo);
}

__device__ __forceinline__ void phase_prologue(CP P, const int tid, const int bid, const int nblk, LAS unsigned char* lds) {
    const int lane = tid & 63, wave = __builtin_amdgcn_readfirstlane(tid >> 6);
    const int gw = bid * NWAVES + wave, NGW = nblk * NWAVES;
    unsigned char* ws = P->ws;
    cvt_layer(P, tid, lds, 0, -1, bid, nblk);
    {
        f32x4 nv[4];
        if (gw < T) { const float* src = gw < TP ? P->in[0] + (size_t)gw * D : P->in[1] + (size_t)(gw - TP) * D;
#pragma unroll
            for (int j = 0; j < 4; ++j) nv[j] = ((const f32x4*)src)[lane + 64 * j]; }
        for (int row = gw; row < T; row += NGW) {
            f32x4 v[4];
#pragma unroll
            for (int j = 0; j < 4; ++j) v[j] = nv[j];
            const int nr = row + NGW;
            if (nr < T) { const float* src = nr < TP ? P->in[0] + (size_t)nr * D : P->in[1] + (size_t)(nr - TP) * D;
#pragma unroll
                for (int j = 0; j < 4; ++j) nv[j] = ((const f32x4*)src)[lane + 64 * j]; }
            store_xhat(v, (bf16_t*)(ws + W_XB) + (size_t)row * D, (float*)(ws + W_INVR) + row, lane);
        }
    }
    const int gt = bid * NTHREADS + tid, NGT = nblk * NTHREADS;
    for (int i = gt; i < 16 * 128; i += NGT) { const int h = i >> 7, d = i & 127; ((float*)(ws + W_BIAST))[i] = P->in[29][t5_bucket(d) * 16 + h]; }
    for (int i = gt; i < 128 * 124 * 32; i += NGT) { const int c4 = i & 31, r = (i >> 5) % 124, b = (i >> 5) / 124;
        const size_t so = ((size_t)b * WIN + r + 4) * 128 + c4 * 4, dq = ((size_t)b * WIN + r) * 128 + c4 * 4;
        *(f32x4*)(P->out + O_KS + dq) = *(const f32x4*)(P->in[4] + so); *(f32x4*)(P->out + O_VS + dq) = *(const f32x4*)(P->in[5] + so); }
}

__device__ __forceinline__ void phase_fixup(CP P, const int tid, const int bid, const int nblk, float alpha, const float* gpost, const bool last) {
    const int lane = tid & 63, wave = tid >> 6;
    const int gw = bid * NWAVES + wave, NGW = nblk * NWAVES;
    const bf16_t* Fb = (const bf16_t*)(P->ws + W_F);
    bf16_t* XR = (bf16_t*)(P->ws + W_XB);
    float* invr = (float*)(P->ws + W_INVR);
    f32x4 gv[4];
#pragma unroll
    for (int j = 0; j < 4; ++j) gv[j] = ((const f32x4*)gpost)[lane + 64 * j];
    u32x2 nf[4], nx[4]; float nsc = 0.f;
    if (gw < T) {
        const u32x2* fr = (const u32x2*)(Fb + (size_t)gw * D) + lane; const u32x2* xr = (const u32x2*)(XR + (size_t)gw * D) + lane;
#pragma unroll
        for (int j = 0; j < 4; ++j) { nf[j] = fr[64 * j]; nx[j] = xr[64 * j]; }
        nsc = invr[gw];
    }
    for (int row = gw; row < T; row += NGW) {
        u32x2 cf[4], cx[4]; const float csc = nsc;
#pragma unroll
        for (int j = 0; j < 4; ++j) { cf[j] = nf[j]; cx[j] = nx[j]; }
        if (row + NGW < T) {
            const u32x2* fr = (const u32x2*)(Fb + (size_t)(row + NGW) * D) + lane; const u32x2* xr = (const u32x2*)(XR + (size_t)(row + NGW) * D) + lane;
#pragma unroll
            for (int j = 0; j < 4; ++j) { nf[j] = fr[64 * j]; nx[j] = xr[64 * j]; }
            nsc = invr[row + NGW];
        }
        f32x4 f[4], v[4]; float s = 0.f;
#pragma unroll
        for (int j = 0; j < 4; ++j) { const u32x2 w = cf[j]; f[j] = (f32x4){bflo(w.x), bfhi(w.x), bflo(w.y), bfhi(w.y)};
            const u32x2 q = cx[j]; v[j] = (f32x4){bflo(q.x), bfhi(q.x), bflo(q.y), bfhi(q.y)} * csc;
            s += (f[j].x * f[j].x + f[j].y * f[j].y) + (f[j].z * f[j].z + f[j].w * f[j].w); }
        const float rs = rsqrtf(wave_sum(s, lane) * (1.0f / D) + RMS_EPS) * alpha;
#pragma unroll
        for (int j = 0; j < 4; ++j) v[j] += f[j] * gv[j] * rs;
        if (last) { f32x4* xo = (f32x4*)(P->out + O_Y + (size_t)row * D);
#pragma unroll
            for (int j = 0; j < 4; ++j) xo[lane + 64 * j] = v[j]; }
        else store_xhat(v, XR + (size_t)row * D, invr + row, lane);
    }
}

struct SsmCoef { float lbr, lbi; float Br[16], Bi[16]; };
__device__ __forceinline__ void ssm_coef(CP P, int l, int g, int p, SsmCoef& c) {
    const int idx = (l * NG + g) * NP + p;
    const float lr = P->in[11][idx], li = P->in[12][idx], dt = expf(P->in[13][idx]);
    const float a = lr * dt, th = li * dt;
    float sn, cs; sincosf(th, &sn, &cs);
    const float e = expf(a);
    c.lbr = e * cs; c.lbi = e * sn;
    float sh, ch; sincosf(0.5f * th, &sh, &ch);
    const float m1r = expm1f(a) * cs - 2.0f * sh * sh, m1i = c.lbi;
    const float den = 1.0f / (lr * lr + li * li);
    const float cr = (m1r * lr + m1i * li) * den, ci = (m1i * lr - m1r * li) * den;
    const f32x4* br = (const f32x4*)(P->in[14] + (size_t)idx * 16); const f32x4* bi = (const f32x4*)(P->in[15] + (size_t)idx * 16);
#pragma unroll
    for (int q = 0; q < 4; ++q) { const f32x4 r = br[q], i = bi[q];
#pragma unroll
        for (int j = 0; j < 4; ++j) { c.Br[4 * q + j] = cr * r[j] - ci * i[j]; c.Bi[4 * q + j] = cr * i[j] + ci * r[j]; } }
}
typedef short bf16x4s __attribute__((ext_vector_type(4)));
constexpr int USB = 136;
constexpr int BUS = 132;
constexpr int XSS = 136;
constexpr int SSM_WAVE_LDS = 16 * BUS * 4 + 16 * XSS * 2;
constexpr int SSM_U_LDS = 64 * USB * 2;

__device__ __forceinline__ void ssm_fetch_u(CP P, const int tid, int row0, int gs, u32x4 (&w)[2]) {
    const bf16_t* xb = (const bf16_t*)(P->ws + W_XB);
#pragma unroll
    for (int i = 0; i < 2; ++i) { const int idx = tid + NTHREADS * i, t = idx >> 4, c8 = idx & 15; w[i] = *(const u32x4*)(xb + (size_t)(row0 + t) * D + gs * 128 + c8 * 8); }
}
__device__ __forceinline__ void ssm_put_u(CP P, const int tid, int l, int gs, const u32x4 (&wv)[2], LAS bf16_t* uT) {
    const float* g2 = P->in[6] + (l * 6 + 2) * D + gs * 128;
#pragma unroll
    for (int i = 0; i < 2; ++i) { const int idx = tid + NTHREADS * i, t = idx >> 4, c8 = idx & 15; const u32x4 w = wv[i];
        const f32x4 ga = *(const f32x4*)(g2 + c8 * 8), gb = *(const f32x4*)(g2 + c8 * 8 + 4);
        u32x4 o; o.x = cvt_pk_bf16(bflo(w.x) * ga.x, bfhi(w.x) * ga.y); o.y = cvt_pk_bf16(bflo(w.y) * ga.z, bfhi(w.y) * ga.w);
        o.z = cvt_pk_bf16(bflo(w.z) * gb.x, bfhi(w.z) * gb.y); o.w = cvt_pk_bf16(bflo(w.w) * gb.z, bfhi(w.w) * gb.w);
        *(LAS u32x4*)(uT + t * USB + c8 * 8) = o; }
}
__device__ __forceinline__ void ssm_setup(CP P, int l, int g, int lane, LAS float* buL, float& lbr, float& lbi, bf16x4s (&Bf)[8]) {
    const int fr = lane & 15, fq = lane >> 4;
    SsmCoef cf; ssm_coef(P, l, g, lane, cf);
    lbr = cf.lbr; lbi = cf.lbi;
    LAS bf16_t* BL = (LAS bf16_t*)buL;
    asm volatile("s_waitcnt lgkmcnt(0)" ::: "memory");
    u32x4 w0, w1, w2, w3;
    w0.x = cvt_pk_bf16(cf.Br[0], cf.Br[1]); w0.y = cvt_pk_bf16(cf.Br[2], cf.Br[3]); w0.z = cvt_pk_bf16(cf.Br[4], cf.Br[5]); w0.w = cvt_pk_bf16(cf.Br[6], cf.Br[7]);
    w1.x = cvt_pk_bf16(cf.Br[8], cf.Br[9]); w1.y = cvt_pk_bf16(cf.Br[10], cf.Br[11]); w1.z = cvt_pk_bf16(cf.Br[12], cf.Br[13]); w1.w = cvt_pk_bf16(cf.Br[14], cf.Br[15]);
    w2.x = cvt_pk_bf16(cf.Bi[0], cf.Bi[1]); w2.y = cvt_pk_bf16(cf.Bi[2], cf.Bi[3]); w2.z = cvt_pk_bf16(cf.Bi[4], cf.Bi[5]); w2.w = cvt_pk_bf16(cf.Bi[6], cf.Bi[7]);
    w3.x = cvt_pk_bf16(cf.Bi[8], cf.Bi[9]); w3.y = cvt_pk_bf16(cf.Bi[10], cf.Bi[11]); w3.z = cvt_pk_bf16(cf.Bi[12], cf.Bi[13]); w3.w = cvt_pk_bf16(cf.Bi[14], cf.Bi[15]);
    *(LAS u32x4*)(BL + lane * 16) = w0; *(LAS u32x4*)(BL + lane * 16 + 8) = w1;
    *(LAS u32x4*)(BL + (64 + lane) * 16) = w2; *(LAS u32x4*)(BL + (64 + lane) * 16 + 8) = w3;
    asm volatile("s_waitcnt lgkmcnt(0)" ::: "memory");
#pragma unroll
    for (int nt = 0; nt < 8; ++nt) Bf[nt] = *(const LAS bf16x4s*)(BL + ((nt >> 2) * 64 + 16 * (nt & 3) + fr) * 16 + 4 * fq);
    asm volatile("s_waitcnt lgkmcnt(0)" ::: "memory");
}
__device__ __forceinline__ void ssm_bu(const bf16x4s uf, const bf16x4s (&Bf)[8], LAS float* buL, int fr, int fq) {
#pragma unroll
    for (int nt = 0; nt < 8; ++nt) {
        const f32x4 d = __builtin_amdgcn_mfma_f32_16x16x16bf16_1k(uf, Bf[nt], (f32x4){0.f, 0.f, 0.f, 0.f}, 0, 0, 0);
#pragma unroll
        for (int j = 0; j < 4; ++j) buL[(4 * fq + j) * BUS + 2 * (16 * (nt & 3) + fr) + (nt >> 2)] = d[j];
    }
    asm volatile("s_waitcnt lgkmcnt(0)" ::: "memory");
}

__device__ __forceinline__ void phase_ssm_a(CP P, const int tid, const int bid, const int nblk, int l, LAS unsigned char* lds) {
    const int lane = tid & 63, wave = __builtin_amdgcn_readfirstlane(tid >> 6), fr = lane & 15, fq = lane >> 4;
    LAS bf16_t* uT = (LAS bf16_t*)lds;
    LAS float* buL = (LAS float*)(lds + SSM_U_LDS + wave * SSM_WAVE_LDS);
    f32x2* sfin = (f32x2*)(P->ws + W_SFIN);
    for (int unit = bid; unit < 256; unit += nblk) {
        const int r = unit & 15, gs = (unit >> 4) & 7, b = unit >> 7;
        if (r == 15) continue;
        const int g = gs * 8 + wave;
        u32x4 wpre[2]; ssm_fetch_u(P, tid, b * SEQ + (r * 8) * 64, gs, wpre);
        float lbr, lbi; bf16x4s Bf[8];
        ssm_setup(P, l, g, lane, buL, lbr, lbi, Bf);
        float xr = 0.f, xi = 0.f;
        for (int cc = 0; cc < 8; ++cc) {
            __syncthreads();
            ssm_put_u(P, tid, l, gs, wpre, uT);
            if (cc + 1 < 8) ssm_fetch_u(P, tid, b * SEQ + (r * 8 + cc + 1) * 64, gs, wpre);
            __syncthreads();
            for (int sub = 0; sub < 4; ++sub) {
                const bf16x4s uf = *(const LAS bf16x4s*)(uT + (sub * 16 + fr) * USB + wave * 16 + 4 * fq);
                ssm_bu(uf, Bf, buL, fr, fq);
#pragma unroll
                for (int t = 0; t < 16; ++t) { const f32x2 bb = *(const LAS f32x2*)(buL + t * BUS + 2 * lane);
                    const float nr = lbr * xr - lbi * xi + bb.x, ni = lbr * xi + lbi * xr + bb.y; xr = nr; xi = ni; }
                asm volatile("s_waitcnt lgkmcnt(0)" ::: "memory");
            }
        }
        sfin[((size_t)(b * 16 + r) * NG + g) * NP + lane] = (f32x2){xr, xi};
    }
}

__device__ __forceinline__ float gelu_tanh(float y) {
    const float z = 0.7978845608028654f * (y + 0.044715f * y * y * y);
    return y * fast_sigmoid(2.0f * z);
}

__device__ __forceinline__ void phase_ssm_b(CP P, const int tid, const int bid, const int nblk, int l, LAS unsigned char* lds) {
    const int lane = tid & 63, wave = __builtin_amdgcn_readfirstlane(tid >> 6), fr = lane & 15, fq = lane >> 4;
    LAS bf16_t* uT = (LAS bf16_t*)lds;
    LAS float* buL = (LAS float*)(lds + SSM_U_LDS + wave * SSM_WAVE_LDS);
    LAS bf16_t* XS = (LAS bf16_t*)(lds + SSM_U_LDS + wave * SSM_WAVE_LDS + 16 * BUS * 4);
    const f32x2* sfin = (const f32x2*)(P->ws + W_SFIN);
    bf16_t* GB = (bf16_t*)(P->ws + W_QB);
    const bf16_t* xb = (const bf16_t*)(P->ws + W_XB);
    for (int unit = bid; unit < 512; unit += nblk) {
        const bool sample = unit >= 256;
        int g, b = 0, r = 0, gs = 0, b4 = 0;
        if (!sample) { r = unit & 15; gs = (unit >> 4) & 7; b = unit >> 7; g = gs * 8 + wave; }
        else { const int wt = (unit - 256) * 8 + wave; b4 = wt >> 6; g = wt & 63; }
        u32x4 wpre[2];
        if (!sample) ssm_fetch_u(P, tid, b * SEQ + (r * 8) * 64, gs, wpre);
        float x0r[4], x0i[4];
        if (sample) {
#pragma unroll
            for (int q = 0; q < 4; ++q) { const size_t si = (((size_t)l * 128 + (b4 * 4 + q)) * NG + g) * NP + lane; x0r[q] = P->in[2][si]; x0i[q] = P->in[3][si]; }
        } else {
#pragma unroll
            for (int q = 0; q < 4; ++q) { x0r[q] = 0.f; x0i[q] = 0.f; }
        }
        float lbr, lbi; bf16x4s Bf[8];
        ssm_setup(P, l, g, lane, buL, lbr, lbi, Bf);
        bf16x8 Cf[4];
        {
            const float* cre = P->in[16] + ((size_t)(l * NG + g) * GS + fr) * NP; const float* cim = P->in[17] + ((size_t)(l * NG + g) * GS + fr) * NP;
#pragma unroll
            for (int ks = 0; ks < 4; ++ks) {
                const f32x4 a = *(const f32x4*)(cre + 4 * fq + 16 * ks), bq = *(const f32x4*)(cim + 4 * fq + 16 * ks);
                u32x4 w; w.x = cvt_pk_bf16(a.x, -bq.x); w.y = cvt_pk_bf16(a.y, -bq.y); w.z = cvt_pk_bf16(a.z, -bq.z); w.w = cvt_pk_bf16(a.w, -bq.w);
                Cf[ks] = __builtin_bit_cast(bf16x8, w); }
        }
        const f32x4 dch = *(const f32x4*)(P->in[18] + l * D + g * 16 + 4 * fq);
        float xr = 0.f, xi = 0.f;
        if (!sample) {
            float ar = lbr, ai = lbi;
#pragma unroll
            for (int q = 0; q < 9; ++q) { const float nr = ar * ar - ai * ai, ni = 2.f * ar * ai; ar = nr; ai = ni; }
            const f32x2* sp = sfin + ((size_t)(b * 16) * NG + g) * NP + lane;
            f32x2 sv[15];
#pragma unroll
            for (int j = 0; j < 15; ++j) sv[j] = j < r ? sp[(size_t)j * NG * NP] : (f32x2){0.f, 0.f};
#pragma unroll
            for (int j = 0; j < 15; ++j) if (j < r) { const float nr = ar * xr - ai * xi + sv[j].x, ni = ar * xi + ai * xr + sv[j].y; xr = nr; xi = ni; }
        }
        const int nchunk = sample ? 1 : 8, nsub = sample ? 1 : 4;
        for (int cc = 0; cc < nchunk; ++cc) {
            const int row0 = sample ? TP + b4 * 16 : b * SEQ + (r * 8 + cc) * 64;
            if (!sample) { __syncthreads(); ssm_put_u(P, tid, l, gs, wpre, uT); if (cc + 1 < 8) ssm_fetch_u(P, tid, row0 + 64, gs, wpre); __syncthreads(); }
            for (int sub = 0; sub < nsub; ++sub) {
                bf16x4s uf;
                if (!sample) uf = *(const LAS bf16x4s*)(uT + (sub * 16 + fr) * USB + wave * 16 + 4 * fq);
                else { const u32x2 w = *(const u32x2*)(xb + (size_t)(row0 + fr) * D + g * 16 + 4 * fq);
                    const f32x4 gg = *(const f32x4*)(P->in[6] + (l * 6 + 2) * D + g * 16 + 4 * fq);
                    u32x2 o; o.x = cvt_pk_bf16(bflo(w.x) * gg.x, bfhi(w.x) * gg.y); o.y = cvt_pk_bf16(bflo(w.y) * gg.z, bfhi(w.y) * gg.w);
                    uf = __builtin_bit_cast(bf16x4s, o); }
                ssm_bu(uf, Bf, buL, fr, fq);
#pragma unroll
                for (int t = 0; t < 16; ++t) {
                    if (sample && (t & 3) == 0) { xr = x0r[t >> 2]; xi = x0i[t >> 2]; }
                    const f32x2 bb = *(const LAS f32x2*)(buL + t * BUS + 2 * lane);
                    const float nr = lbr * xr - lbi * xi + bb.x, ni = lbr * xi + lbi * xr + bb.y; xr = nr; xi = ni;
                    *(LAS unsigned*)(XS + t * XSS + 2 * lane) = cvt_pk_bf16(xr, xi);
                    if (sample && (t & 3) == 3) { const size_t si = (((size_t)l * 128 + (b4 * 4 + (t >> 2))) * NG + g) * NP + lane; P->out[O_RES + si] = xr; P->out[O_IMS + si] = xi; }
                }
                asm volatile("s_waitcnt lgkmcnt(0)" ::: "memory");
                f32x4 y = (f32x4){0.f, 0.f, 0.f, 0.f};
#pragma unroll
                for (int ks = 0; ks < 4; ++ks) { const bf16x8 a = *(const LAS bf16x8*)(XS + fr * XSS + fq * 8 + 32 * ks); y = __builtin_amdgcn_mfma_f32_16x16x32_bf16(Cf[ks], a, y, 0, 0, 0); }
                {
                    const int tl = sub * 16 + fr;
                    f32x4 uu;
                    if (!sample) { const u32x2 w = *(const LAS u32x2*)(uT + tl * USB + wave * 16 + 4 * fq); uu = (f32x4){bflo(w.x), bfhi(w.x), bflo(w.y), bfhi(w.y)}; }
                    else { const u32x2 w = *(const u32x2*)(xb + (size_t)(row0 + tl) * D + g * 16 + 4 * fq); const f32x4 gg = *(const f32x4*)(P->in[6] + (l * 6 + 2) * D + g * 16 + 4 * fq);
                        const unsigned a0 = cvt_pk_bf16(bflo(w.x) * gg.x, bfhi(w.x) * gg.y), a1 = cvt_pk_bf16(bflo(w.y) * gg.z, bfhi(w.y) * gg.w);
                        uu = (f32x4){bflo(a0), bfhi(a0), bflo(a1), bfhi(a1)}; }
                    u32x2 o; o.x = cvt_pk_bf16(gelu_tanh(y[0] + dch[0] * uu[0]), gelu_tanh(y[1] + dch[1] * uu[1])); o.y = cvt_pk_bf16(gelu_tanh(y[2] + dch[2] * uu[2]), gelu_tanh(y[3] + dch[3] * uu[3]));
                    *(u32x2*)(GB + (size_t)(row0 + tl) * D + g * 16 + 4 * fq) = o;
                }
                asm volatile("s_waitcnt lgkmcnt(0)" ::: "memory");
            }
        }
        if (!sample && r == 15) { const size_t si = (((size_t)l * 2 + b) * NG + g) * NP + lane; P->out[O_REP + si] = xr; P->out[O_IMP + si] = xi; }
    }
}

constexpr int KST = 72, VST = 264;
__device__ __forceinline__ void phase_attn_prompt(CP P, const int tid, const int bid, const int nblk, int bl, LAS unsigned char* lds) {
    const int lane = tid & 63, wave = tid >> 6, fr = lane & 15, fq = lane >> 4;
    LAS bf16_t* Ks = (LAS bf16_t*)lds;
    LAS bf16_t* Vt = (LAS bf16_t*)(lds + 36864);
    LAS float* bL = (LAS float*)(lds + 36864 + 33792);
    const bf16_t* kvb = (const bf16_t*)(P->ws + W_KVB);
    const bf16_t* Qb = (const bf16_t*)(P->ws + W_QB);
    bf16_t* Ob = (bf16_t*)(P->ws + W_OB);
    const float* biasT = (const float*)(P->ws + W_BIAST);
    for (int unit = bid; unit < 256; unit += nblk) {
        const int kvh = unit & 1, nb = (unit >> 1) & 63, b = unit >> 7;
        __syncthreads();
#pragma unroll
        for (int i = 0; i < 4; ++i) { const int q = tid + NTHREADS * i, key = q >> 3, c8 = q & 7;
            const int pos = (nb - 1) * 128 + key;
            u32x4 kw = (u32x4){0u, 0u, 0u, 0u}, vw = kw;
            if (pos >= 0) { const bf16_t* src = kvb + (size_t)(b * SEQ + pos) * 256 + kvh * 64 + c8 * 8; kw = *(const u32x4*)src; vw = *(const u32x4*)(src + 128); }
            *(LAS u32x4*)(Ks + key * KST + c8 * 8) = kw;
            LAS bf16_t* vd = Vt + (c8 * 8) * VST + key;
            vd[0 * VST] = (bf16_t)(vw.x & 0xffff); vd[1 * VST] = (bf16_t)(vw.x >> 16); vd[2 * VST] = (bf16_t)(vw.y & 0xffff); vd[3 * VST] = (bf16_t)(vw.y >> 16);
            vd[4 * VST] = (bf16_t)(vw.z & 0xffff); vd[5 * VST] = (bf16_t)(vw.z >> 16); vd[6 * VST] = (bf16_t)(vw.w & 0xffff); vd[7 * VST] = (bf16_t)(vw.w >> 16); }
#pragma unroll
        for (int i = 0; i < 2; ++i) { const int q = tid + NTHREADS * i; bL[q] = biasT[(kvh * 8) * 128 + q]; }
        __syncthreads();
        const int qs = wave, t0 = qs < 6 ? qs : 6;
        const int iq = 16 * qs + fr;
        const size_t qrow = (size_t)b * SEQ + nb * 128 + iq;
        bf16x8 q0n = *(const bf16x8*)(Qb + qrow * D + kvh * 512 + fq * 8), q1n = *(const bf16x8*)(Qb + qrow * D + kvh * 512 + 32 + fq * 8);
        for (int hq = 0; hq < 8; ++hq) {
            const int h = kvh * 8 + hq;
            int iql = iq; asm volatile("" : "+v"(iql));
            const int lim = nb > 0 ? 127 : iql;
            const bf16x8 q0 = q0n, q1 = q1n;
            if (hq < 7) { q0n = *(const bf16x8*)(Qb + qrow * D + (h + 1) * 64 + fq * 8); q1n = *(const bf16x8*)(Qb + qrow * D + (h + 1) * 64 + 32 + fq * 8); }
            const float sink = P->in[26][bl * 16 + h];
            f32x4 S[10];
            float mx = -INFINITY;
#pragma unroll
            for (int tt = 0; tt < 10; ++tt) {
                const int key = (t0 + tt) * 16 + fr;
                const bf16x8 k0 = *(const LAS bf16x8*)(Ks + key * KST + fq * 8), k1 = *(const LAS bf16x8*)(Ks + key * KST + 32 + fq * 8);
                f32x4 s = (f32x4){0.f, 0.f, 0.f, 0.f};
                s = __builtin_amdgcn_mfma_f32_16x16x32_bf16(k0, q0, s, 0, 0, 0);
                s = __builtin_amdgcn_mfma_f32_16x16x32_bf16(k1, q1, s, 0, 0, 0);
#pragma unroll
                for (int j = 0; j < 4; ++j) { const int jb = (t0 + tt) * 16 + 4 * fq + j, dist = 128 + iql - jb;
                    const float pen = __int_as_float((((lim - dist) | dist) >> 31) & (int)0xff800000);
                    const float v = s[j] + bL[hq * 128 + (dist & 127)] + pen;
                    s[j] = v; mx = fmaxf(mx, v); }
                S[tt] = s;
            }
            mx = fmaxf(mx, swz_xor(mx, 0x401f)); mx = fmaxf(mx, xor32(mx, lane)); mx = fmaxf(mx, sink);
            float sum = 0.f;
#pragma unroll
            for (int tt = 0; tt < 10; ++tt)
#pragma unroll
                for (int j = 0; j < 4; ++j) { const float p = __expf(S[tt][j] - mx); S[tt][j] = p; sum += p; }
            sum += swz_xor(sum, 0x401f); sum += xor32(sum, lane);
            const float inv = 1.0f / (sum + __expf(sink - mx));
            f32x4 O[4];
#pragma unroll
            for (int dt = 0; dt < 4; ++dt) O[dt] = (f32x4){0.f, 0.f, 0.f, 0.f};
#pragma unroll
            for (int s5 = 0; s5 < 5; ++s5) {
                const f32x4 pa = S[2 * s5] * inv, pb = S[2 * s5 + 1] * inv;
                u32x4 pw; pw.x = cvt_pk_bf16(pa[0], pa[1]); pw.y = cvt_pk_bf16(pa[2], pa[3]); pw.z = cvt_pk_bf16(pb[0], pb[1]); pw.w = cvt_pk_bf16(pb[2], pb[3]);
                const bf16x8 pf = __builtin_bit_cast(bf16x8, pw);
                const int ka = 16 * (t0 + 2 * s5) + 4 * fq, kb = ka + 16;
#pragma unroll
                for (int dt = 0; dt < 4; ++dt) {
                    const LAS bf16_t* vr = Vt + (dt * 16 + fr) * VST;
                    const u32x2 va = *(const LAS u32x2*)(vr + ka), vb = *(const LAS u32x2*)(vr + kb);
                    const u32x4 vw = (u32x4){va.x, va.y, vb.x, vb.y};
                    O[dt] = __builtin_amdgcn_mfma_f32_16x16x32_bf16(__builtin_bit_cast(bf16x8, vw), pf, O[dt], 0, 0, 0);
                }
            }
#pragma unroll
            for (int dt = 0; dt < 4; ++dt) { u32x2 w; w.x = cvt_pk_bf16(O[dt][0], O[dt][1]); w.y = cvt_pk_bf16(O[dt][2], O[dt][3]);
                *(u32x2*)(Ob + qrow * D + h * 64 + dt * 16 + 4 * fq) = w; }
        }
    }
}

__device__ __forceinline__ void phase_attn_sample(CP P, const int tid, const int bid, const int nblk, int bl, LAS unsigned char* lds) {
    const int lane = tid & 63, wave = tid >> 6;
    LAS float* qL = (LAS float*)(lds + 80000 + wave * 4096);
    LAS float* pL = qL + 256;
    const bf16_t* kvb = (const bf16_t*)(P->ws + W_KVB);
    const bf16_t* Qb = (const bf16_t*)(P->ws + W_QB);
    bf16_t* Ob = (bf16_t*)(P->ws + W_OB);
    const float* biasT = (const float*)(P->ws + W_BIAST);
    const int gw = bid * NWAVES + wave, NGW = nblk * NWAVES;
    for (int task = gw; task < 128 * 16; task += NGW) {
        const int h = task & 15, b = task >> 4, kvh = h >> 3;
        const size_t row0 = (size_t)TP + b * 4;
        asm volatile("s_waitcnt lgkmcnt(0)" ::: "memory");
#pragma unroll
        for (int t = 0; t < 4; ++t) qL[t * 64 + lane] = bf2f(Qb[(row0 + t) * D + h * 64 + lane]);
        asm volatile("s_waitcnt lgkmcnt(0)" ::: "memory");
        const float sink = P->in[26][bl * 16 + h];
        float sc[3][4];
#pragma unroll
        for (int r = 0; r < 3; ++r) {
            const int j = lane + 64 * r;
            float a0 = 0.f, a1 = 0.f, a2 = 0.f, a3 = 0.f;
            if (j < 128) {
                const f32x4* kr = (const f32x4*)(P->in[4] + ((size_t)(b * WIN + j) * 2 + kvh) * 64);
#pragma unroll 8
                for (int d4 = 0; d4 < 16; ++d4) { const f32x4 kv = kr[d4];
                    const f32x4 qa = *(const LAS f32x4*)(qL + d4 * 4), qb = *(const LAS f32x4*)(qL + 64 + d4 * 4), qc = *(const LAS f32x4*)(qL + 128 + d4 * 4), qd = *(const LAS f32x4*)(qL + 192 + d4 * 4);
                    a0 += kv.x * qa.x + kv.y * qa.y + kv.z * qa.z + kv.w * qa.w; a1 += kv.x * qb.x + kv.y * qb.y + kv.z * qb.z + kv.w * qb.w;
                    a2 += kv.x * qc.x + kv.y * qc.y + kv.z * qc.z + kv.w * qc.w; a3 += kv.x * qd.x + kv.y * qd.y + kv.z * qd.z + kv.w * qd.w; }
            } else if (j < 132) {
                const u32x2* kr = (const u32x2*)(kvb + (row0 + (j - 128)) * 256 + kvh * 64);
#pragma unroll 4
                for (int d4 = 0; d4 < 16; ++d4) { const u32x2 w = kr[d4]; const f32x4 kv = (f32x4){bflo(w.x), bfhi(w.x), bflo(w.y), bfhi(w.y)};
                    const f32x4 qa = *(const LAS f32x4*)(qL + d4 * 4), qb = *(const LAS f32x4*)(qL + 64 + d4 * 4), qc = *(const LAS f32x4*)(qL + 128 + d4 * 4), qd = *(const LAS f32x4*)(qL + 192 + d4 * 4);
                    a0 += kv.x * qa.x + kv.y * qa.y + kv.z * qa.z + kv.w * qa.w; a1 += kv.x * qb.x + kv.y * qb.y + kv.z * qb.z + kv.w * qb.w;
                    a2 += kv.x * qc.x + kv.y * qc.y + kv.z * qc.z + kv.w * qc.w; a3 += kv.x * qd.x + kv.y * qd.y + kv.z * qd.z + kv.w * qd.w; }
            }
            const float a[4] = {a0, a1, a2, a3};
#pragma unroll
            for (int t = 0; t < 4; ++t) { const int dist = 128 + t - j; const bool valid = j < 132 && dist >= 0 && dist < WIN;
                sc[r][t] = valid ? a[t] + biasT[h * 128 + (dist & 127)] : -INFINITY; }
        }
#pragma unroll
        for (int t = 0; t < 4; ++t) {
            float mx = fmaxf(fmaxf(sc[0][t], sc[1][t]), sc[2][t]); mx = fmaxf(wave_max(mx, lane), sink);
            const float p0 = __expf(sc[0][t] - mx), p1 = __expf(sc[1][t] - mx), p2 = __expf(sc[2][t] - mx);
            const float sum = wave_sum(p0 + p1 + p2, lane);
            const float inv = 1.0f / (sum + __expf(sink - mx));
            pL[t * 136 + lane] = p0 * inv; pL[t * 136 + 64 + lane] = p1 * inv; if (lane < 8) pL[t * 136 + 128 + lane] = p2 * inv;
        }
        asm volatile("s_waitcnt lgkmcnt(0)" ::: "memory");
        float o0 = 0.f, o1 = 0.f, o2 = 0.f, o3 = 0.f;
        const float* vc = P->in[5] + ((size_t)(b * WIN) * 2 + kvh) * 64 + lane;
#pragma unroll 32
        for (int j = 0; j < 128; ++j) { const float v = vc[(size_t)j * 128];
            o0 += pL[j] * v; o1 += pL[136 + j] * v; o2 += pL[272 + j] * v; o3 += pL[408 + j] * v; }
#pragma unroll
        for (int j = 128; j < 132; ++j) { const float v = bf2f(kvb[(row0 + (j - 128)) * 256 + 128 + kvh * 64 + lane]);
            o0 += pL[j] * v; o1 += pL[136 + j] * v; o2 += pL[272 + j] * v; o3 += pL[408 + j] * v; }
        Ob[(row0 + 0) * D + h * 64 + lane] = f2bf(o0); Ob[(row0 + 1) * D + h * 64 + lane] = f2bf(o1);
        Ob[(row0 + 2) * D + h * 64 + lane] = f2bf(o2); Ob[(row0 + 3) * D + h * 64 + lane] = f2bf(o3);
    }
}


#define XB_TMO      128
#define XB_XCNT(j)  (256  + 64 * (j))
#define XB_XSUB(j)  (1280 + 64 * (j))
#define XB_XGEN(j)  (2304 + 64 * (j))
#define XB_TOP      3328
#define XB_TOPGEN   3392
#define XCD_BAR_WORDS 3456
#define XB_SPIN_CAP (1u << 22)
__device__ __forceinline__ unsigned xb_ld(unsigned* p)              { return __hip_atomic_load(p, __ATOMIC_RELAXED, __HIP_MEMORY_SCOPE_AGENT); }
__device__ __forceinline__ unsigned xb_add(unsigned* p, unsigned v) { return __hip_atomic_fetch_add(p, v, __ATOMIC_RELAXED, __HIP_MEMORY_SCOPE_AGENT); }
__device__ __forceinline__ unsigned xb_xcc_id() { return (unsigned)__builtin_amdgcn_s_getreg((3 << 11) | 20) & 0xFu; }
#define XB_SPIN(cond, bar) do { unsigned _sp = 0; while (cond) { __builtin_amdgcn_s_sleep(1); \
    if ((++_sp & 255u) == 0u) { if (xb_ld(&(bar)[XB_TMO])) break; if (_sp > XB_SPIN_CAP) { atomicAdd(&(bar)[XB_TMO], 1u); break; } } } } while (0)
struct XcdBarrier { unsigned* bar; unsigned x; volatile LAS unsigned* st; };
__device__ __forceinline__ XcdBarrier xcd_barrier_post(unsigned* bar, volatile LAS unsigned* st) {
    XcdBarrier b; b.bar = bar; b.x = xb_xcc_id(); b.st = st;
    if (threadIdx.x == 0) (void)xb_add(&bar[XB_XCNT(b.x)], 1u);
    return b;
}
__device__ __forceinline__ void xcd_barrier_complete(unsigned* bar, unsigned x, unsigned& nloc, unsigned& nx) {
    const unsigned G = gridDim.x * gridDim.y * gridDim.z;
    unsigned sum, cnt, mine, sp = 0u;
    for (;;) {
        sum = 0u; cnt = 0u; mine = 0u;
#pragma unroll
        for (unsigned j = 0; j < 16; ++j) { const unsigned c = xb_ld(&bar[XB_XCNT(j)]); sum += c; cnt += (c > 0u) ? 1u : 0u; mine = (j == x) ? c : mine; }
        if (sum == G) break;
        __builtin_amdgcn_s_sleep(1);
        if ((++sp & 255u) == 0u) { if (xb_ld(&bar[XB_TMO])) break; if (sp > XB_SPIN_CAP) { atomicAdd(&bar[XB_TMO], 1u); break; } }
    }
    nloc = mine > 0u ? mine : 1u; nx = cnt > 0u ? cnt : 1u;
}
__device__ __forceinline__ void xcd_barrier(const XcdBarrier& b) {
    asm volatile("s_waitcnt vmcnt(0)" ::: "memory");
    __syncthreads();
    if (threadIdx.x == 0) {
        unsigned* bar = b.bar; asm volatile("" : "+s"(bar));
        __builtin_amdgcn_s_waitcnt(0);
        unsigned nloc = b.st[0], nx = b.st[1];
        if (nloc == 0u) { xcd_barrier_complete(bar, b.x, nloc, nx); b.st[0] = nloc; b.st[1] = nx; }
        const unsigned old = xb_add(&bar[XB_XSUB(b.x)], 1u);
        const unsigned gen = old / nloc;
        if (old + 1u == (gen + 1u) * nloc) {
            __builtin_amdgcn_fence(__ATOMIC_RELEASE, "agent");
            asm volatile("s_waitcnt vmcnt(0)" ::: "memory");
            const unsigned og = xb_add(&bar[XB_TOP], 1u);
            const unsigned tg = og / nx;
            if (og + 1u == (tg + 1u) * nx) xb_add(&bar[XB_TOPGEN], 1u);
            else XB_SPIN(xb_ld(&bar[XB_TOPGEN]) == tg, bar);
            __builtin_amdgcn_fence(__ATOMIC_ACQUIRE, "agent");
            xb_add(&bar[XB_XGEN(b.x)], 1u);
            asm volatile("s_waitcnt vmcnt(0)" ::: "memory");
        } else {
            XB_SPIN(xb_ld(&bar[XB_XGEN(b.x)]) == gen, bar);
            __builtin_amdgcn_fence(__ATOMIC_ACQUIRE, "agent");
            asm volatile("s_waitcnt vmcnt(0)" ::: "memory");
        }
    }
    __syncthreads();
}

__device__ __forceinline__ void run_gemm_gated0(CP P, const int tid, const int bid, const int nblk, LAS unsigned char* lds, const bf16_t* A, const bf16_t* Bt, int N, int K, bf16_t* O, int ldc) {
    pg8::gemm_phase<pg8::EpiGated<0>>(tid, lds, A, Bt, T, N, K, nblk, bid, O, ldc, nullptr, 1.0f, nullptr, 0);
}
__device__ __forceinline__ void run_gemm_gated1(CP P, const int tid, const int bid, const int nblk, LAS unsigned char* lds, const bf16_t* A, const bf16_t* Bt, int N, int K, bf16_t* O, int ldc, const float* bias, int nout) {
    pg8::gemm_phase<pg8::EpiGated<1>>(tid, lds, A, Bt, TP, N, K, nblk, bid, O, ldc, bias, 1.0f, nullptr, nout);
    small_gemm<1>(tid, bid, nblk, lds, A, Bt, N, K, O, ldc, bias, 1.0f, nout);
}
__device__ __forceinline__ void run_gemm_plain(CP P, const int tid, const int bid, const int nblk, LAS unsigned char* lds, const bf16_t* A, const bf16_t* Bt, int N, int K, bf16_t* O, int ldc, const float* bias, float scale) {
    pg8::gemm_phase<pg8::EpiBf16<0>>(tid, lds, A, Bt, TP, N, K, nblk, bid, O, ldc, bias, scale, nullptr, 0);
    small_gemm<0>(tid, bid, nblk, lds, A, Bt, N, K, O, ldc, bias, scale, 0);
}
__device__ __forceinline__ void run_gemm_kv(CP P, const int tid, const int bid, const int nblk, LAS unsigned char* lds) {
    pg8::gemm_phase<pg8::EpiBf16<1>>(tid, lds, (const bf16_t*)(P->ws + W_XB), (const bf16_t*)(P->ws + W_KV), T, 256, D, nblk, (bid + 84) % nblk, (bf16_t*)(P->ws + W_KVB), 256, P->in[23], 1.0f, P->out, 0);
}

__global__ void __launch_bounds__(NTHREADS, 2) mega(Params Pval) {
    extern __shared__ __attribute__((aligned(16))) unsigned char shm[];
    LAS unsigned char* lds = (LAS unsigned char*)shm;
    CP P = launder((CP)__builtin_amdgcn_kernarg_segment_ptr());
    const int ph_lo = P->ph_lo, ph_hi = P->ph_hi;
    volatile LAS unsigned* xst = (volatile LAS unsigned*)(lds + 131072);
    if (threadIdx.x == 0) { xst[0] = 0u; xst[1] = 0u; xst[2] = 0u; xst[3] = 0u; }
    __syncthreads();
    XcdBarrier xb = xcd_barrier_post((unsigned*)(P->ws + W_BAR), xst);
    for (int ph = ph_lo; ph < ph_hi; ++ph) {
    P = launder(P);
    int tid = threadIdx.x, bid = blockIdx.x, nblk = gridDim.x;
    asm volatile("" : "+v"(tid)); const int tid0 = tid; asm volatile("" : "+s"(bid)); asm volatile("" : "+s"(nblk));
    unsigned char* ws = P->ws;
    const bf16_t* XB = (const bf16_t*)(ws + W_XB);
    bf16_t* HB = (bf16_t*)(ws + W_H);
    bf16_t* FB = (bf16_t*)(ws + W_F);
    bf16_t* QB = (bf16_t*)(ws + W_QB);
    bf16_t* OB = (bf16_t*)(ws + W_OB);
    {
        if (ph == 0) { REPLOOP(REP_PRO) phase_prologue(P, tid, bid, nblk, lds); }
        else {
            const int l = (ph - 1) / 10, s = (ph - 1) % 10;
            const float* ng = P->in[6] + (size_t)l * 6 * D;
            if (s == 0 || s == 7) {
                const int f = s == 7;
                if (l == 2 && f == 0) run_gemm_kv(P, tid, bid, nblk, lds);
                REPLOOP(REP_GU)
                run_gemm_gated0(P, tid, bid, nblk, lds, XB, (const bf16_t*)(ws + W_GU) + (size_t)(l * 2 + f) * 2 * FF * D, 2 * FF, D, HB, FF);
                if (l < 2) cvt_in_shadow(P, tid, bid, nblk, lds, l + 1, f);
                else if (l == 2 && f == 1) cvt_in_shadow(P, tid, bid, nblk, lds, 3, 0);
                else if (l == 3 && f == 0) cvt_in_shadow(P, tid, bid, nblk, lds, 3, 1);
            } else if (s == 1 || s == 8) {
                const int f = s == 8;
                REPLOOP(REP_DN)
                run_gemm_plain(P, tid, bid, nblk, lds, HB, (const bf16_t*)(ws + W_DN) + (size_t)(l * 2 + f) * D * FF, D, FF, FB, D, nullptr, 1.0f);
            } else if (s == 2) phase_fixup(P, tid, bid, nblk, 0.5f, ng + 1 * D, false);
            else if (s == 6) phase_fixup(P, tid, bid, nblk, 1.0f, ng + 3 * D, false);
            else if (s == 9) phase_fixup(P, tid, bid, nblk, 0.5f, ng + 5 * D, l == 3);
            else if (s == 3) {
                REPLOOP(REP_MX)
                if (l < 2) phase_ssm_a(P, tid, bid, nblk, l, lds);
                else run_gemm_plain(P, tid, bid, nblk, lds, XB, (const bf16_t*)(ws + W_Q) + (size_t)(l - 2) * D * D, D, D, QB, D, P->in[25] + (l - 2) * D, 0.125f);
            } else if (s == 4) {
                REPLOOP(REP_MX)
                if (l < 2) phase_ssm_b(P, tid, bid, nblk, l, lds);
                else { phase_attn_prompt(P, tid, bid, nblk, l - 2, lds); phase_attn_sample(P, tid, bid, nblk, l - 2, lds); }
            } else if (s == 5) {
                if (l < 2) run_gemm_gated1(P, tid, bid, nblk, lds, QB, (const bf16_t*)(ws + W_GLU) + (size_t)l * 2 * D * D, 2 * D, D, FB, D, P->in[20] + l * 2 * D, D);
                else run_gemm_plain(P, tid, bid, nblk, lds, OB, (const bf16_t*)(ws + W_O) + (size_t)(l - 2) * D * D, D, D, FB, D, P->in[28] + (l - 2) * D, 1.0f);
            }
        }
        if (ph + 1 < ph_hi) { if (ph < 0) cg::this_grid().sync(); else xcd_barrier(xb); }
    }
    }
}

extern "C" void kernel_launch(void* const* d_in, const int* in_sizes, int n_in, void* d_out, int out_size, void* d_ws, size_t ws_size, hipStream_t stream) {
    static int grid = 0;
    if (grid == 0) {
        if (n_in != 30 || (size_t)out_size != O_END || ws_size < W_END) { fprintf(stderr, "kernel_launch: unexpected shapes n_in %d out %d ws %zu (need %zu)\n", n_in, out_size, ws_size, (size_t)W_END); grid = -1; return; }
        int dev = 0, cus = 0, per_cu = 0;
        hipGetDevice(&dev);
        hipDeviceGetAttribute(&cus, hipDeviceAttributeMultiprocessorCount, dev);
        if (hipFuncSetAttribute((const void*)mega, hipFuncAttributeMaxDynamicSharedMemorySize, LDS_BYTES) != hipSuccess) { fprintf(stderr, "kernel_launch: hipFuncSetAttribute failed\n"); grid = -1; return; }
        hipOccupancyMaxActiveBlocksPerMultiprocessor(&per_cu, (const void*)mega, NTHREADS, LDS_BYTES);
        if (per_cu < 1) { fprintf(stderr, "kernel_launch: occupancy query says %d blocks per CU\n", per_cu); per_cu = 1; }
        (void)hipGetLastError();
        grid = cus * 1;
    }
    if (grid < 0) return;
    if (hipMemsetAsync((char*)d_ws + W_BAR, 0, 3456 * 4, stream) != hipSuccess) { fprintf(stderr, "kernel_launch: memset failed\n"); return; }
    Params p{};
    for (int i = 0; i < 30; ++i) p.in[i] = (const float*)d_in[i];
    p.out = (float*)d_out; p.ws = (unsigned char*)d_ws;
#if MK_MULTI
    for (int ph = 0; ph < NPHASES; ++ph) { p.ph_lo = ph; p.ph_hi = ph + 1; hipLaunchKernelGGL(mega, dim3(grid), dim3(NTHREADS), LDS_BYTES, stream, p); }
#else
    p.ph_lo = 0; p.ph_hi = NPHASES;
    void* args[] = {&p};
    hipError_t e = hipLaunchCooperativeKernel((const void*)mega, dim3(grid), dim3(NTHREADS), args, LDS_BYTES, stream);
    if (e != hipSuccess) fprintf(stderr, "cooperative launch failed: %s (grid %d)\n", hipGetErrorString(e), grid);
#endif
}
```

```cpp
#include <hip/hip_runtime.h>
#include <hip/hip_cooperative_groups.h>
#include <cstdio>
namespace cg = cooperative_groups;

#ifndef MK_MULTI
#define MK_MULTI 0
#endif

#ifndef REP_PRO
#define REP_PRO 1
#define REP_GU 1
#define REP_DN 1
#define REP_MX 1
#define REP_FX 1
#endif
#define REPLOOP(n) for (int rep = 0, tid = tid0; rep < (n); ++rep, ({ asm volatile("" : "+v"(tid)); }))
#define LAS __attribute__((address_space(3)))
typedef unsigned short bf16_t;
typedef short bf16x8 __attribute__((ext_vector_type(8)));
typedef short bf16x4 __attribute__((ext_vector_type(4)));
typedef float f32x4 __attribute__((ext_vector_type(4)));
typedef float f32x2 __attribute__((ext_vector_type(2)));
typedef unsigned u32x4 __attribute__((ext_vector_type(4)));
typedef unsigned u32x2 __attribute__((ext_vector_type(2)));

constexpr int D = 1024, FF = 2816, TP = 16384, TS = 512, T = TP + TS, SEQ = 8192;
constexpr int NG = 64, NP = 64, GS = 16;
constexpr int WIN = 128;
constexpr float RMS_EPS = 1e-6f;
constexpr int NTHREADS = 512, NWAVES = 8;
constexpr int LDS_BYTES = 131072 + 16;
constexpr int NPHASES = 41;

constexpr size_t O_Y = 0;
constexpr size_t O_REP = (size_t)T * D;
constexpr size_t O_IMP = O_REP + 16384;
constexpr size_t O_KP = O_IMP + 16384;
constexpr size_t O_VP = O_KP + 32768;
constexpr size_t O_RES = O_VP + 32768;
constexpr size_t O_IMS = O_RES + 1048576;
constexpr size_t O_KS = O_IMS + 1048576;
constexpr size_t O_VS = O_KS + 2097152;
constexpr size_t O_END = O_VS + 2097152;

constexpr size_t W_GU = 0;
constexpr size_t W_DN = W_GU + (size_t)8 * 5632 * 1024 * 2;
constexpr size_t W_GLU = W_DN + (size_t)8 * 1024 * 2816 * 2;
constexpr size_t W_Q = W_GLU + (size_t)2 * 2048 * 1024 * 2;
constexpr size_t W_O = W_Q + (size_t)2 * 1024 * 1024 * 2;
constexpr size_t W_KV = W_O + (size_t)2 * 1024 * 1024 * 2;
constexpr size_t W_XB = W_KV + (size_t)256 * 1024 * 2;
constexpr size_t W_H = W_XB + (size_t)T * D * 2;
constexpr size_t W_QB = W_H;
constexpr size_t W_OB = W_H + (size_t)T * D * 2;
constexpr size_t W_F = W_H + (size_t)T * FF * 2;
constexpr size_t W_KVB = W_F + (size_t)T * D * 2;
constexpr size_t W_SFIN = W_KVB + (size_t)T * 256 * 2;
constexpr size_t W_BIAST = W_SFIN + (size_t)2 * 128 * 64 * 64 * 8;
constexpr size_t W_INVR = W_BIAST + 16 * 128 * 4;
constexpr size_t W_BAR = W_INVR + (size_t)T * 4 + 1024;
constexpr size_t W_END = W_BAR + 3456 * 4;

struct Params {
    const float* in[30];
    float* out;
    unsigned char* ws;
    int ph_lo, ph_hi;
};
typedef __attribute__((address_space(4))) const Params* CP;
__device__ __forceinline__ CP launder(CP p) { asm volatile("" : "+s"(p)); return p; }

__device__ __forceinline__ unsigned cvt_pk_bf16(float lo, float hi) { unsigned r; asm volatile("v_cvt_pk_bf16_f32 %0, %1, %2" : "=v"(r) : "v"(lo), "v"(hi)); return r; }
__device__ __forceinline__ bf16_t f2bf(float f) { return (bf16_t)(cvt_pk_bf16(f, 0.f) & 0xffffu); }
__device__ __forceinline__ float bf2f(unsigned b) { return __uint_as_float(b << 16); }
__device__ __forceinline__ float bflo(unsigned w) { return __uint_as_float(w << 16); }
__device__ __forceinline__ float bfhi(unsigned w) { return __uint_as_float(w & 0xffff0000u); }
#define swz_xor(v, pat) __int_as_float(__builtin_amdgcn_ds_swizzle(__float_as_int(v), (pat)))
__device__ __forceinline__ float xor32(float v, int lane) { return __int_as_float(__builtin_amdgcn_ds_bpermute((lane ^ 32) << 2, __float_as_int(v))); }
__device__ __forceinline__ float wave_sum(float v, int lane) {
    v += swz_xor(v, 0x041f); v += swz_xor(v, 0x081f); v += swz_xor(v, 0x101f); v += swz_xor(v, 0x201f); v += swz_xor(v, 0x401f);
    return v + xor32(v, lane);
}
__device__ __forceinline__ float wave_max(float v, int lane) {
    v = fmaxf(v, swz_xor(v, 0x041f)); v = fmaxf(v, swz_xor(v, 0x081f)); v = fmaxf(v, swz_xor(v, 0x101f)); v = fmaxf(v, swz_xor(v, 0x201f)); v = fmaxf(v, swz_xor(v, 0x401f));
    return fmaxf(v, xor32(v, lane));
}
__device__ __forceinline__ float fast_sigmoid(float x) { return __builtin_amdgcn_rcpf(1.0f + __expf(-x)); }

namespace pg8 {
constexpr int BM = 256, BK = 64, HALF = 128, HTB = HALF * BK * 2, STAGE_BYTES = 8 * HTB, NXCD = 8, WGM = 8;
__device__ __forceinline__ int lds_byte(int r, int c) { const int st = (r >> 4) * 2 + (c >> 5), rr = r & 15, cc = c & 31, ob = rr * 64 + cc * 2; return st * 1024 + (ob ^ (((ob >> 9) & 1) << 5)); }
__device__ __forceinline__ void stage_rc(int b, int& R, int& C) { const int st = b / 1024, sb = b % 1024, swz = sb ^ (((sb >> 9) & 1) << 5); R = (st >> 1) * 16 + swz / 64; C = (st & 1) * 32 + (swz % 64) / 2; }
__device__ __forceinline__ int perm32(int rho) { const int n = rho >> 4, i = rho & 15; return 8 * (i >> 2) + 4 * n + (i & 3); }

struct Unit { int pm, pn; };

struct StaticOrder {
    int nM, nN, nwg, G, c;
    __device__ void init(int M, int N, int G_, int c_) { nM = M / BM; nN = N / BM; nwg = nM * nN; G = G_; c = c_; }
    __device__ bool next(int i, Unit& u) const {
        const long L = (long)i * G + c; if (L >= nwg) return false;
        int wgid = (int)L; { const int q = nwg / NXCD, r = nwg % NXCD, xcd = wgid % NXCD, off = wgid / NXCD; wgid = (xcd < r ? xcd * (q + 1) : r * (q + 1) + (xcd - r) * q) + off; }
        const int nig = WGM * nN, gid = wgid / nig, fm = gid * WGM, gsz = (nM - fm) < WGM ? (nM - fm) : WGM;
        u.pm = fm + ((wgid % nig) % gsz); u.pn = (wgid % nig) / gsz; return true;
    }
};

template <class Epi>
__device__ __forceinline__ void gemm_phase(const int tid, LAS unsigned char* lds, const bf16_t* gA, const bf16_t* gBt, const int gM, const int gN, const int gK, const int gridn, const int cidx,
                                           bf16_t* eO, const int eldc, const float* ebias, const float escale, float* eout, const int enout) {
    StaticOrder S; S.init(gM, gN, gridn, cidx);
    struct { const bf16_t* A; const bf16_t* Bt; int K; } g{gA, gBt, gK};
    const int wid = __builtin_amdgcn_readfirstlane(tid >> 6), lane = tid & 63, wr = wid >> 2, wc = wid & 3, fr = lane & 15, fq = lane >> 4;
    const int K = g.K, nt = K / BK;
    unsigned voffA[2], voffB[2];
#pragma unroll
    for (int i = 0; i < 2; ++i) { int R, C; stage_rc(tid * 16 + i * 8192, R, C); const int Rb = Epi::PERM ? ((R & ~31) + perm32(R & 31)) : R;
        voffA[i] = (unsigned)(R * K + C) * 2u; voffB[i] = (unsigned)(Rb * K + C) * 2u; }
    const size_t kstep = (size_t)(BK * 2);
    const size_t hstep = (size_t)HALF * K * 2;
    const size_t tstep = 2 * hstep;
    const unsigned ldsw = (unsigned)wid * 1024u;
    const int aoff = lds_byte(wr * 64 + fr, fq * 8), boff = lds_byte(wc * 32 + fr, fq * 8);
#define PG8_SA(b, h) (((b) * 2 + (h)) * HTB)
#define PG8_SB(b, h) ((4 + (b) * 2 + (h)) * HTB)
#define PG8_STAGE(bufoff, gbase, voff) do { _Pragma("unroll") for (int _i = 0; _i < 2; ++_i) \
        __builtin_amdgcn_global_load_lds((const unsigned*)((const char*)(gbase) + (voff)[_i]), (LAS unsigned*)(lds + (bufoff) + ldsw + _i * 8192), 16, 0, 0); } while (0)
#define PG8_LDA(dst, b, h) do { _Pragma("unroll") for (int m = 0; m < 4; ++m) _Pragma("unroll") for (int k = 0; k < 2; ++k) dst[m][k] = *(const LAS bf16x8*)(lds + PG8_SA(b, h) + aoff + m * 2048 + k * 1024); } while (0)
#define PG8_LDB(dst, b, h) do { _Pragma("unroll") for (int n = 0; n < 2; ++n) _Pragma("unroll") for (int k = 0; k < 2; ++k) dst[n][k] = *(const LAS bf16x8*)(lds + PG8_SB(b, h) + boff + n * 2048 + k * 1024); } while (0)
#define PG8_MMA(ai, bj, At, Bt) do { __builtin_amdgcn_s_setprio(1); _Pragma("unroll") for (int m = 0; m < 4; ++m) _Pragma("unroll") for (int n = 0; n < 2; ++n) _Pragma("unroll") for (int k = 0; k < 2; ++k) \
        acc[ai][bj][m][n] = __builtin_amdgcn_mfma_f32_16x16x32_bf16(Bt[n][k], At[m][k], acc[ai][bj][m][n], 0, 0, 0); __builtin_amdgcn_s_setprio(0); } while (0)
#define PG8_WAIT_V(n) asm volatile("s_waitcnt vmcnt(" #n ")" ::: "memory")
#define PG8_WAIT_L(n) asm volatile("s_waitcnt lgkmcnt(" #n ")" ::: "memory")
#define PG8_BAR __builtin_amdgcn_s_barrier()
#define PG8_SCHED __builtin_amdgcn_sched_barrier(0)
    Unit cur, nxt; int ui = 0;
    if (!S.next(0, cur)) return;
    f32x4 acc[2][2][4][2];
#pragma unroll
    for (int a = 0; a < 2; ++a)
#pragma unroll
        for (int b = 0; b < 2; ++b)
#pragma unroll
            for (int m = 0; m < 4; ++m)
#pragma unroll
                for (int n = 0; n < 2; ++n) acc[a][b][m][n] = (f32x4){0.f, 0.f, 0.f, 0.f};
    bf16x8 At[4][2], B0[2][2], B1[2][2];
    const char* cA = (const char*)g.A + (size_t)cur.pm * tstep; const char* cB = (const char*)g.Bt + (size_t)cur.pn * tstep;
    PG8_STAGE(PG8_SB(0, 0), cB, voffB); PG8_STAGE(PG8_SA(0, 0), cA, voffA); PG8_STAGE(PG8_SB(0, 1), cB + hstep, voffB); PG8_STAGE(PG8_SA(0, 1), cA + hstep, voffA);
    if (wr == 1) PG8_BAR;
    PG8_WAIT_V(4); PG8_BAR;
    PG8_STAGE(PG8_SB(1, 0), cB + kstep, voffB); PG8_STAGE(PG8_SA(1, 0), cA + kstep, voffA); PG8_STAGE(PG8_SB(1, 1), cB + hstep + kstep, voffB);
    PG8_WAIT_V(6); PG8_BAR;
    for (;;) {
        const bool has_next = S.next(ui + 1, nxt);
        const char* nA = has_next ? (const char*)g.A + (size_t)nxt.pm * tstep : cA; const char* nB = has_next ? (const char*)g.Bt + (size_t)nxt.pn * tstep : cB;
        for (int t = 0; t < nt; t += 2) {
            const bool last = (t == nt - 2);
            const char* a1 = cA + (size_t)(t + 1) * kstep;
            const char* a2 = last ? nA : cA + (size_t)(t + 2) * kstep; const char* b2 = last ? nB : cB + (size_t)(t + 2) * kstep;
            const char* a3 = a2 + kstep; const char* b3 = b2 + kstep;
            PG8_LDB(B0, 0, 0); PG8_SCHED; PG8_LDA(At, 0, 0); PG8_STAGE(PG8_SA(1, 1), a1 + hstep, voffA);
            PG8_WAIT_L(8); PG8_BAR; PG8_WAIT_L(0); PG8_MMA(0, 0, At, B0); PG8_BAR; PG8_SCHED;
            PG8_LDB(B1, 0, 1); PG8_STAGE(PG8_SB(0, 0), b2, voffB);
            PG8_BAR; PG8_WAIT_L(0); PG8_MMA(0, 1, At, B1); PG8_BAR;
            PG8_LDA(At, 0, 1); PG8_STAGE(PG8_SA(0, 0), a2, voffA);
            PG8_BAR; PG8_WAIT_L(0); PG8_MMA(1, 0, At, B0); PG8_BAR; PG8_SCHED;
            PG8_STAGE(PG8_SB(0, 1), b2 + hstep, voffB);
            PG8_WAIT_V(6); PG8_BAR; PG8_MMA(1, 1, At, B1); PG8_BAR;
            PG8_LDB(B0, 1, 0); PG8_SCHED; PG8_LDA(At, 1, 0); PG8_STAGE(PG8_SA(0, 1), a2 + hstep, voffA);
            PG8_WAIT_L(8); PG8_BAR; PG8_WAIT_L(0); PG8_MMA(0, 0, At, B0); PG8_BAR; PG8_SCHED;
            PG8_LDB(B1, 1, 1); PG8_STAGE(PG8_SB(1, 0), b3, voffB);
            PG8_BAR; PG8_WAIT_L(0); PG8_MMA(0, 1, At, B1); PG8_BAR;
            PG8_LDA(At, 1, 1); PG8_STAGE(PG8_SA(1, 0), a3, voffA);
            PG8_BAR; PG8_WAIT_L(0); PG8_MMA(1, 0, At, B0); PG8_BAR; PG8_SCHED;
            PG8_STAGE(PG8_SB(1, 1), b3 + hstep, voffB);
            PG8_WAIT_V(6); PG8_BAR; PG8_MMA(1, 1, At, B1); PG8_BAR;
        }
        Epi::run(acc, cur, wr, wc, fr, fq, eO, eldc, ebias, escale, eout, enout);
        if (!has_next) break;
#pragma unroll
        for (int a = 0; a < 2; ++a)
#pragma unroll
            for (int b = 0; b < 2; ++b)
#pragma unroll
                for (int m = 0; m < 4; ++m)
#pragma unroll
                    for (int n = 0; n < 2; ++n) acc[a][b][m][n] = (f32x4){0.f, 0.f, 0.f, 0.f};
        cur = nxt; cA = nA; cB = nB; ++ui;
    }
    PG8_WAIT_V(0);
    if (wr == 0) PG8_BAR;
    PG8_BAR;
#undef PG8_SA
#undef PG8_SB
#undef PG8_STAGE
#undef PG8_LDA
#undef PG8_LDB
#undef PG8_MMA
#undef PG8_WAIT_V
#undef PG8_WAIT_L
#undef PG8_BAR
#undef PG8_SCHED
}

template <int MODE> struct EpiGated {
    static constexpr bool PERM = true;
    static __device__ __forceinline__ void run(const f32x4 (&acc)[2][2][4][2], const Unit& u, int wr, int wc, int fr, int fq, bf16_t* O, int ldc, const float* bias, float scale, float* out, int nout) {
        const int row0 = u.pm * BM + wr * 64 + fr, col0 = u.pn * HALF + wc * 32 + 8 * fq;
        f32x4 ba[2], bb[2];
        if (MODE == 1) {
#pragma unroll
            for (int n = 0; n < 2; ++n) { ba[n] = *(const f32x4*)(bias + col0 + 4 * n); bb[n] = *(const f32x4*)(bias + nout + col0 + 4 * n); }
        }
#pragma unroll
        for (int ai = 0; ai < 2; ++ai)
#pragma unroll
            for (int m = 0; m < 4; ++m) {
                bf16_t* rowp = O + (size_t)(row0 + ai * HALF + m * 16) * ldc + col0;
                float o[8];
                if (MODE == 0) {
#pragma unroll
                    for (int n = 0; n < 2; ++n)
#pragma unroll
                        for (int h = 0; h < 2; ++h) {
                            const f32x2 a = (f32x2){acc[ai][0][m][n][2 * h], acc[ai][0][m][n][2 * h + 1]}, b = (f32x2){acc[ai][1][m][n][2 * h], acc[ai][1][m][n][2 * h + 1]};
                            const f32x2 t = a * (-1.4426950408889634f);
                            f32x2 e; e.x = __builtin_amdgcn_exp2f(t.x); e.y = __builtin_amdgcn_exp2f(t.y);
                            const f32x2 d = e + 1.0f;
                            f32x2 r; r.x = __builtin_amdgcn_rcpf(d.x); r.y = __builtin_amdgcn_rcpf(d.y);
                            const f32x2 v = (a * b) * r;
                            o[4 * n + 2 * h] = v.x; o[4 * n + 2 * h + 1] = v.y;
                        }
                } else {
#pragma unroll
                    for (int n = 0; n < 2; ++n)
#pragma unroll
                        for (int j = 0; j < 4; ++j) { const float a = acc[ai][0][m][n][j], b = acc[ai][1][m][n][j]; o[4 * n + j] = (a + ba[n][j]) * fast_sigmoid(b + bb[n][j]); }
                }
                u32x4 w; w.x = cvt_pk_bf16(o[0], o[1]); w.y = cvt_pk_bf16(o[2], o[3]); w.z = cvt_pk_bf16(o[4], o[5]); w.w = cvt_pk_bf16(o[6], o[7]);
                *(u32x4*)rowp = w;
            }
    }
};
template <int KV> struct EpiBf16 {
    static constexpr bool PERM = true;
    static __device__ __forceinline__ void run(const f32x4 (&acc)[2][2][4][2], const Unit& u, int wr, int wc, int fr, int fq, bf16_t* O, int ldc, const float* bias, float scale, float* out, int nout) {
        const int row0 = u.pm * BM + wr * 64 + fr, col0 = u.pn * BM + wc * 32 + 8 * fq;
        f32x4 bv[2][2];
#pragma unroll
        for (int bj = 0; bj < 2; ++bj)
#pragma unroll
            for (int n = 0; n < 2; ++n) bv[bj][n] = bias ? *(const f32x4*)(bias + col0 + bj * HALF + 4 * n) : (f32x4){0.f, 0.f, 0.f, 0.f};
#pragma unroll
        for (int ai = 0; ai < 2; ++ai)
#pragma unroll
            for (int m = 0; m < 4; ++m) {
                const int row = row0 + ai * HALF + m * 16;
                bf16_t* rowp = O + (size_t)row * ldc + col0;
                float* wrow = nullptr;
                size_t vdelta = 0;
                if (KV) {
                    if (row < TP) { const int b = row >> 13, s = row & (SEQ - 1); if (s >= SEQ - WIN) { wrow = out + O_KP + ((size_t)b * WIN + (s - (SEQ - WIN))) * 128; vdelta = O_VP - O_KP; } }
                    else { const int rr = row - TP, b = rr >> 2, t = rr & 3; wrow = out + O_KS + ((size_t)b * WIN + (WIN - 4 + t)) * 128; vdelta = O_VS - O_KS; }
                }
#pragma unroll
                for (int bj = 0; bj < 2; ++bj) {
                    const f32x4 v0 = (acc[ai][bj][m][0] + bv[bj][0]) * scale, v1 = (acc[ai][bj][m][1] + bv[bj][1]) * scale;
                    u32x4 w; w.x = cvt_pk_bf16(v0[0], v0[1]); w.y = cvt_pk_bf16(v0[2], v0[3]); w.z = cvt_pk_bf16(v1[0], v1[1]); w.w = cvt_pk_bf16(v1[2], v1[3]);
                    *(u32x4*)(rowp + bj * HALF) = w;
                    if (KV) { if (wrow) { float* dst = wrow + (bj ? vdelta : 0) + (col0 & 127);
                        *(f32x4*)dst = v0; *(f32x4*)(dst + 4) = v1; } }
                }
            }
    }
};
}


constexpr int SGS = 68;
template <int GATED>
__device__ __forceinline__ void small_gemm(const int tid, const int bid, const int nblk, LAS unsigned char* lds, const bf16_t* A, const bf16_t* Bt, const int N, const int K,
                                           bf16_t* O, const int ldc, const float* bias, const float scale, const int nout) {
    const int lane = tid & 63, wave = __builtin_amdgcn_readfirstlane(tid >> 6), fr = lane & 15, fq = lane >> 4;
    LAS float* part = (LAS float*)lds;
    const int ncol = GATED ? nout / 32 : N / 64, nunits = (TS / 32) * ncol;
    const int kw = K / 8, nks = kw / 32;
    for (int unit = bid; unit < nunits; unit += nblk) {
        const int rt = unit / ncol, ct = unit % ncol;
        const int r0 = TP + rt * 32;
        int brow[4];
#pragma unroll
        for (int f = 0; f < 4; ++f) {
            if (GATED) { const int oc0 = ct * 32, base = (oc0 >> 7) * 256 + (oc0 & 127); brow[f] = base + (f >> 1) * 128 + (f & 1) * 16 + fr; }
            else brow[f] = ct * 64 + f * 16 + fr;
        }
        const bf16_t* ap0 = A + (size_t)(r0 + fr) * K + wave * kw + fq * 8;
        const bf16_t* ap1 = ap0 + (size_t)16 * K;
        const bf16_t* bp[4];
#pragma unroll
        for (int f = 0; f < 4; ++f) bp[f] = Bt + (size_t)brow[f] * K + wave * kw + fq * 8;
        f32x4 acc[2][4];
#pragma unroll
        for (int i = 0; i < 2; ++i)
#pragma unroll
            for (int f = 0; f < 4; ++f) acc[i][f] = (f32x4){0.f, 0.f, 0.f, 0.f};
        bf16x8 pa0[2], pa1[2], pb[2][4], qa0[2], qa1[2], qb[2][4];
#define SG_LOAD(A0, A1, B, KS) do { _Pragma("unroll") for (int u = 0; u < 2; ++u) if ((KS) + u < nks) { const int ko = ((KS) + u) * 32; \
            A0[u] = *(const bf16x8*)(ap0 + ko); A1[u] = *(const bf16x8*)(ap1 + ko); _Pragma("unroll") for (int f = 0; f < 4; ++f) B[u][f] = *(const bf16x8*)(bp[f] + ko); } } while (0)
#define SG_MMA(A0, A1, B, KS) do { _Pragma("unroll") for (int u = 0; u < 2; ++u) if ((KS) + u < nks) { _Pragma("unroll") for (int f = 0; f < 4; ++f) { \
            acc[0][f] = __builtin_amdgcn_mfma_f32_16x16x32_bf16(A0[u], B[u][f], acc[0][f], 0, 0, 0); acc[1][f] = __builtin_amdgcn_mfma_f32_16x16x32_bf16(A1[u], B[u][f], acc[1][f], 0, 0, 0); } } } while (0)
        SG_LOAD(pa0, pa1, pb, 0);
        for (int ks0 = 0; ks0 < nks; ks0 += 4) {
            if (ks0 + 2 < nks) SG_LOAD(qa0, qa1, qb, ks0 + 2);
            SG_MMA(pa0, pa1, pb, ks0);
            if (ks0 + 4 < nks) SG_LOAD(pa0, pa1, pb, ks0 + 4);
            if (ks0 + 2 < nks) SG_MMA(qa0, qa1, qb, ks0 + 2);
        }
#undef SG_LOAD
#undef SG_MMA
        __syncthreads();
#pragma unroll
        for (int i = 0; i < 2; ++i)
#pragma unroll
            for (int f = 0; f < 4; ++f)
#pragma unroll
                for (int j = 0; j < 4; ++j) part[(wave * 32 + 16 * i + 4 * fq + j) * SGS + 16 * f + fr] = acc[i][f][j];
        __syncthreads();
        const int row = tid >> 4, c4 = (tid & 15) * 4;
        f32x4 sum = (f32x4){0.f, 0.f, 0.f, 0.f};
#pragma unroll
        for (int w = 0; w < 8; ++w) sum += *(const LAS f32x4*)(part + (w * 32 + row) * SGS + c4);
        if (!GATED) {
            const int col = ct * 64 + c4;
            f32x4 bv = bias ? *(const f32x4*)(bias + col) : (f32x4){0.f, 0.f, 0.f, 0.f};
            const f32x4 v = (sum + bv) * scale;
            u32x2 w; w.x = cvt_pk_bf16(v[0], v[1]); w.y = cvt_pk_bf16(v[2], v[3]);
            *(u32x2*)(O + (size_t)(r0 + row) * ldc + col) = w;
        } else {
            if (c4 < 32) {
                f32x4 sb = (f32x4){0.f, 0.f, 0.f, 0.f};
#pragma unroll
                for (int w = 0; w < 8; ++w) sb += *(const LAS f32x4*)(part + (w * 32 + row) * SGS + 32 + c4);
                const int col = ct * 32 + c4;
                const f32x4 ba = *(const f32x4*)(bias + col), bb = *(const f32x4*)(bias + nout + col);
                float o[4];
#pragma unroll
                for (int j = 0; j < 4; ++j) o[j] = (sum[j] + ba[j]) * fast_sigmoid(sb[j] + bb[j]);
                u32x2 w; w.x = cvt_pk_bf16(o[0], o[1]); w.y = cvt_pk_bf16(o[2], o[3]);
                *(u32x2*)(O + (size_t)(r0 + row) * ldc + col) = w;
            }
        }
    }
    __syncthreads();
}

constexpr int CTS = 266;
__device__ __forceinline__ void cvt_block_item(const float* W, int K, int Nsrc, bf16_t* WT, int Ndst, int inter, int halfoff, const float* gk, LAS unsigned char* lds, int item, int tid) {
    const int lane = tid & 63, wave = __builtin_amdgcn_readfirstlane(tid >> 6);
    const int nb256 = Ndst / 256, kb = item / nb256, nb = item % nb256, k0 = 64 * kb, r0 = 256 * nb;
    LAS unsigned* Tl = (LAS unsigned*)lds;
    const int r = r0 + 4 * lane, c = inter ? ((r >> 8) * 128 + (r & 127) + ((r >> 7) & 1) * halfoff) : r;
    const float* src = W + (size_t)(k0 + wave * 8) * Nsrc + c;
    f32x4 v[8];
#pragma unroll
    for (int i = 0; i < 8; ++i) v[i] = *(const f32x4*)(src + (size_t)i * Nsrc);
#pragma unroll
    for (int i = 0; i < 8; ++i) { const float gs = gk ? gk[k0 + wave * 8 + i] : 1.0f;
        LAS unsigned* d = Tl + (wave * 8 + i) * (CTS / 2) + 2 * lane;
        d[0] = cvt_pk_bf16(v[i].x * gs, v[i].y * gs); d[1] = cvt_pk_bf16(v[i].z * gs, v[i].w * gs); }
    __syncthreads();
    const LAS bf16_t* Tb = (const LAS bf16_t*)lds;
    const int ch = tid & 7;
#pragma unroll
    for (int i = 0; i < 4; ++i) { const int n = i * 64 + (tid >> 3); const LAS bf16_t* t = Tb + (ch * 8) * CTS + n;
        u32x4 o;
        o.x = (unsigned)t[0 * CTS] | ((unsigned)t[1 * CTS] << 16); o.y = (unsigned)t[2 * CTS] | ((unsigned)t[3 * CTS] << 16);
        o.z = (unsigned)t[4 * CTS] | ((unsigned)t[5 * CTS] << 16); o.w = (unsigned)t[6 * CTS] | ((unsigned)t[7 * CTS] << 16);
        *(u32x4*)(WT + (size_t)(r0 + n) * K + k0 + ch * 8) = o; }
    __syncthreads();
}

__device__ __forceinline__ int t5_bucket(int n) {
    if (n < 16) return n;
    int large = 16 + (int)(logf((float)n / 16.0f) / 2.0794415416798357f * 16.0f);
    return large < 31 ? large : 31;
}

__device__ __forceinline__ void store_xhat(const f32x4 (&v)[4], bf16_t* xbrow, float* invr, int lane) {
    float s = 0.f;
#pragma unroll
    for (int j = 0; j < 4; ++j) s += (v[j].x * v[j].x + v[j].y * v[j].y) + (v[j].z * v[j].z + v[j].w * v[j].w);
    const float ms = wave_sum(s, lane) * (1.0f / D) + RMS_EPS;
    const float rstd = rsqrtf(ms);
    if (lane == 0) *invr = sqrtf(ms);
    u32x2* o8 = (u32x2*)xbrow + lane;
#pragma unroll
    for (int j = 0; j < 4; ++j) { u32x2 w; w.x = cvt_pk_bf16(v[j].x * rstd, v[j].y * rstd); w.y = cvt_pk_bf16(v[j].z * rstd, v[j].w * rstd); o8[64 * j] = w; }
}

__device__ __forceinline__ void cvt_layer(CP P, const int tid, LAS unsigned char* lds, const int layer, const int half, const int widx, const int nw) {
    unsigned char* ws = P->ws;
    int base = 0;
    for (int job = 0; job < 23; ++job) {
        const float* src; int K, Nsrc, Ndst, inter = 0, halfoff = 0, jl, jh; bf16_t* dst; const float* gk = nullptr;
        if (job < 8) { const int l = job >> 1, f = job & 1; jl = l; jh = f; src = P->in[f ? 9 : 7] + (size_t)l * D * 2 * FF; K = D; Nsrc = 2 * FF; Ndst = 2 * FF; inter = 1; halfoff = FF;
            dst = (bf16_t*)(ws + W_GU) + (size_t)job * 2 * FF * D; gk = P->in[6] + (l * 6 + (f ? 4 : 0)) * D; }
        else if (job < 16) { const int j = job - 8, l = j >> 1, f = j & 1; jl = l; jh = f; src = P->in[f ? 10 : 8] + (size_t)l * FF * D; K = FF; Nsrc = D; Ndst = D; dst = (bf16_t*)(ws + W_DN) + (size_t)j * D * FF; }
        else if (job < 18) { const int l = job - 16; jl = l; jh = 0; src = P->in[19] + (size_t)l * D * 2 * D; K = D; Nsrc = 2 * D; Ndst = 2 * D; inter = 1; halfoff = D; dst = (bf16_t*)(ws + W_GLU) + (size_t)l * 2 * D * D; }
        else if (job < 20) { const int bl = job - 18; jl = 2 + bl; jh = 0; src = P->in[24] + (size_t)bl * D * D; K = D; Nsrc = D; Ndst = D; dst = (bf16_t*)(ws + W_Q) + (size_t)bl * D * D; gk = P->in[6] + ((2 + bl) * 6 + 2) * D; }
        else if (job < 22) { const int bl = job - 20; jl = 2 + bl; jh = 0; src = P->in[27] + (size_t)bl * D * D; K = D; Nsrc = D; Ndst = D; dst = (bf16_t*)(ws + W_O) + (size_t)bl * D * D; }
        else { jl = 2; jh = 1; src = P->in[22]; K = D; Nsrc = 256; Ndst = 256; dst = (bf16_t*)(ws + W_KV); gk = P->in[21]; }
        if (jl != layer || (half >= 0 && jh != half)) continue;
        const int nitems = (K / 64) * (Ndst / 256);
        int first = (widx - base) % nw; if (first < 0) first += nw;
        for (int it = first; it < nitems; it += nw) cvt_block_item(src, K, Nsrc, dst, Ndst, inter, halfoff, gk, lds, it, tid);
        base += nitems;
    }
}
__device__ __forceinline__ void cvt_in_shadow(CP P, const int tid, const int bid, const int nblk, LAS unsigned char* lds, const int layer, const int half) {
    const int rem = (66 * 22) % nblk, lo = rem ? rem : 0;
    if (bid < lo) return;
    cvt_layer(P, tid, lds, layer, half, bid - lo, nblk - lo);
}

__device__ __forceinline__ void phase_prologue(CP P, const int tid, const int bid, const int nblk, LAS unsigned char* lds) {
    const int lane = tid & 63, wave = __builtin_amdgcn_readfirstlane(tid >> 6);
    const int gw = bid * NWAVES + wave, NGW = nblk * NWAVES;
    unsigned char* ws = P->ws;
    cvt_layer(P, tid, lds, 0, -1, bid, nblk);
    {
        f32x4 nv[4];
        if (gw < T) { const float* src = gw < TP ? P->in[0] + (size_t)gw * D : P->in[1] + (size_t)(gw - TP) * D;
#pragma unroll
            for (int j = 0; j < 4; ++j) nv[j] = ((const f32x4*)src)[lane + 64 * j]; }
        for (int row = gw; row < T; row += NGW) {
            f32x4 v[4];
#pragma unroll
            for (int j = 0; j < 4; ++j) v[j] = nv[j];
            const int nr = row + NGW;
            if (nr < T) { const float* src = nr < TP ? P->in[0] + (size_t)nr * D : P->in[1] + (size_t)(nr - TP) * D;
#pragma unroll
                for (int j = 0; j < 4; ++j) nv[j] = ((const f32x4*)src)[lane + 64 * j]; }
            store_xhat(v, (bf16_t*)(ws + W_XB) + (size_t)row * D, (float*)(ws + W_INVR) + row, lane);
        }
    }
    const int gt = bid * NTHREADS + tid, NGT = nblk * NTHREADS;
    for (int i = gt; i < 16 * 128; i += NGT) { const int h = i >> 7, d = i & 127; ((float*)(ws + W_BIAST))[i] = P->in[29][t5_bucket(d) * 16 + h]; }
    for (int i = gt; i < 128 * 124 * 32; i += NGT) { const int c4 = i & 31, r = (i >> 5) % 124, b = (i >> 5) / 124;
        const size_t so = ((size_t)b * WIN + r + 4) * 128 + c4 * 4, dq = ((size_t)b * WIN + r) * 128 + c4 * 4;
        *(f32x4*)(P->out + O_KS + dq) = *(const f32x4*)(P->in[4] + so); *(f32x4*)(P->out + O_VS + dq) = *(const f32x4*)(P->in[5] + so); }
}

__device__ __forceinline__ void phase_fixup(CP P, const int tid, const int bid, const int nblk, float alpha, const float* gpost, const bool last) {
    const int lane = tid & 63, wave = tid >> 6;
    const int gw = bid * NWAVES + wave, NGW = nblk * NWAVES;
    const bf16_t* Fb = (const bf16_t*)(P->ws + W_F);
    bf16_t* XR = (bf16_t*)(P->ws + W_XB);
    float* invr = (float*)(P->ws + W_INVR);
    f32x4 gv[4];
#pragma unroll
    for (int j = 0; j < 4; ++j) gv[j] = ((const f32x4*)gpost)[lane + 64 * j];
    u32x2 nf[4], nx[4]; float nsc = 0.f;
    if (gw < T) {
        const u32x2* fr = (const u32x2*)(Fb + (size_t)gw * D) + lane; const u32x2* xr = (const u32x2*)(XR + (size_t)gw * D) + lane;
#pragma unroll
        for (int j = 0; j < 4; ++j) { nf[j] = fr[64 * j]; nx[j] = xr[64 * j]; }
        nsc = invr[gw];
    }
    for (int row = gw; row < T; row += NGW) {
        u32x2 cf[4], cx[4]; const float csc = nsc;
#pragma unroll
        for (int j = 0; j < 4; ++j) { cf[j] = nf[j]; cx[j] = nx[j]; }
        if (row + NGW < T) {
            const u32x2* fr = (const u32x2*)(Fb + (size_t)(row + NGW) * D) + lane; const u32x2* xr = (const u32x2*)(XR + (size_t)(row + NGW) * D) + lane;
#pragma unroll
            for (int j = 0; j < 4; ++j) { nf[j] = fr[64 * j]; nx[j] = xr[64 * j]; }
            nsc = invr[row + NGW];
        }
        f32x4 f[4], v[4]; float s = 0.f;
#pragma unroll
        for (int j = 0; j < 4; ++j) { const u32x2 w = cf[j]; f[j] = (f32x4){bflo(w.x), bfhi(w.x), bflo(w.y), bfhi(w.y)};
            const u32x2 q = cx[j]; v[j] = (f32x4){bflo(q.x), bfhi(q.x), bflo(q.y), bfhi(q.y)} * csc;
            s += (f[j].x * f[j].x + f[j].y * f[j].y) + (f[j].z * f[j].z + f[j].w * f[j].w); }
        const float rs = rsqrtf(wave_sum(s, lane) * (1.0f / D) + RMS_EPS) * alpha;
#pragma unroll
        for (int j = 0; j < 4; ++j) v[j] += f[j] * gv[j] * rs;
        if (last) { f32x4* xo = (f32x4*)(P->out + O_Y + (size_t)row * D);
#pragma unroll
            for (int j = 0; j < 4; ++j) xo[lane + 64 * j] = v[j]; }
        else store_xhat(v, XR + (size_t)row * D, invr + row, lane);
    }
}

struct SsmCoef { float lbr, lbi; float Br[16], Bi[16]; };
__device__ __forceinline__ void ssm_coef(CP P, int l, int g, int p, SsmCoef& c) {
    const int idx = (l * NG + g) * NP + p;
    const float lr = P->in[11][idx], li = P->in[12][idx], dt = expf(P->in[13][idx]);
    const float a = lr * dt, th = li * dt;
    float sn, cs; sincosf(th, &sn, &cs);
    const float e = expf(a);
    c.lbr = e * cs; c.lbi = e * sn;
    float sh, ch; sincosf(0.5f * th, &sh, &ch);
    const float m1r = expm1f(a) * cs - 2.0f * sh * sh, m1i = c.lbi;
    const float den = 1.0f / (lr * lr + li * li);
    const float cr = (m1r * lr + m1i * li) * den, ci = (m1i * lr - m1r * li) * den;
    const f32x4* br = (const f32x4*)(P->in[14] + (size_t)idx * 16); const f32x4* bi = (const f32x4*)(P->in[15] + (size_t)idx * 16);
#pragma unroll
    for (int q = 0; q < 4; ++q) { const f32x4 r = br[q], i = bi[q];
#pragma unroll
        for (int j = 0; j < 4; ++j) { c.Br[4 * q + j] = cr * r[j] - ci * i[j]; c.Bi[4 * q + j] = cr * i[j] + ci * r[j]; } }
}
typedef short bf16x4s __attribute__((ext_vector_type(4)));
constexpr int USB = 136;
constexpr int BUS = 132;
constexpr int XSS = 136;
constexpr int SSM_WAVE_LDS = 16 * BUS * 4 + 16 * XSS * 2;
constexpr int SSM_U_LDS = 64 * USB * 2;

__device__ __forceinline__ void ssm_fetch_u(CP P, const int tid, int row0, int gs, u32x4 (&w)[2]) {
    const bf16_t* xb = (const bf16_t*)(P->ws + W_XB);
#pragma unroll
    for (int i = 0; i < 2; ++i) { const int idx = tid + NTHREADS * i, t = idx >> 4, c8 = idx & 15; w[i] = *(const u32x4*)(xb + (size_t)(row0 + t) * D + gs * 128 + c8 * 8); }
}
__device__ __forceinline__ void ssm_put_u(CP P, const int tid, int l, int gs, const u32x4 (&wv)[2], LAS bf16_t* uT) {
    const float* g2 = P->in[6] + (l * 6 + 2) * D + gs * 128;
#pragma unroll
    for (int i = 0; i < 2; ++i) { const int idx = tid + NTHREADS * i, t = idx >> 4, c8 = idx & 15; const u32x4 w = wv[i];
        const f32x4 ga = *(const f32x4*)(g2 + c8 * 8), gb = *(const f32x4*)(g2 + c8 * 8 + 4);
        u32x4 o; o.x = cvt_pk_bf16(bflo(w.x) * ga.x, bfhi(w.x) * ga.y); o.y = cvt_pk_bf16(bflo(w.y) * ga.z, bfhi(w.y) * ga.w);
        o.z = cvt_pk_bf16(bflo(w.z) * gb.x, bfhi(w.z) * gb.y); o.w = cvt_pk_bf16(bflo(w.w) * gb.z, bfhi(w.w) * gb.w);
        *(LAS u32x4*)(uT + t * USB + c8 * 8) = o; }
}
__device__ __forceinline__ void ssm_setup(CP P, int l, int g, int lane, LAS float* buL, float& lbr, float& lbi, bf16x4s (&Bf)[8]) {
    const int fr = lane & 15, fq = lane >> 4;
    SsmCoef cf; ssm_coef(P, l, g, lane, cf);
    lbr = cf.lbr; lbi = cf.lbi;
    LAS bf16_t* BL = (LAS bf16_t*)buL;
    asm volatile("s_waitcnt lgkmcnt(0)" ::: "memory");
    u32x4 w0, w1, w2, w3;
    w0.x = cvt_pk_bf16(cf.Br[0], cf.Br[1]); w0.y = cvt_pk_bf16(cf.Br[2], cf.Br[3]); w0.z = cvt_pk_bf16(cf.Br[4], cf.Br[5]); w0.w = cvt_pk_bf16(cf.Br[6], cf.Br[7]);
    w1.x = cvt_pk_bf16(cf.Br[8], cf.Br[9]); w1.y = cvt_pk_bf16(cf.Br[10], cf.Br[11]); w1.z = cvt_pk_bf16(cf.Br[12], cf.Br[13]); w1.w = cvt_pk_bf16(cf.Br[14], cf.Br[15]);
    w2.x = cvt_pk_bf16(cf.Bi[0], cf.Bi[1]); w2.y = cvt_pk_bf16(cf.Bi[2], cf.Bi[3]); w2.z = cvt_pk_bf16(cf.Bi[4], cf.Bi[5]); w2.w = cvt_pk_bf16(cf.Bi[6], cf.Bi[7]);
    w3.x = cvt_pk_bf16(cf.Bi[8], cf.Bi[9]); w3.y = cvt_pk_bf16(cf.Bi[10], cf.Bi[11]); w3.z = cvt_pk_bf16(cf.Bi[12], cf.Bi[13]); w3.w = cvt_pk_bf16(cf.Bi[14], cf.Bi[15]);
    *(LAS u32x4*)(BL + lane * 16) = w0; *(LAS u32x4*)(BL + lane * 16 + 8) = w1;
    *(LAS u32x4*)(BL + (64 + lane) * 16) = w2; *(LAS u32x4*)(BL + (64 + lane) * 16 + 8) = w3;
    asm volatile("s_waitcnt lgkmcnt(0)" ::: "memory");
#pragma unroll
    for (int nt = 0; nt < 8; ++nt) Bf[nt] = *(const LAS bf16x4s*)(BL + ((nt >> 2) * 64 + 16 * (nt & 3) + fr) * 16 + 4 * fq);
    asm volatile("s_waitcnt lgkmcnt(0)" ::: "memory");
}
__device__ __forceinline__ void ssm_bu(const bf16x4s uf, const bf16x4s (&Bf)[8], LAS float* buL, int fr, int fq) {
#pragma unroll
    for (int nt = 0; nt < 8; ++nt) {
        const f32x4 d = __builtin_amdgcn_mfma_f32_16x16x16bf16_1k(uf, Bf[nt], (f32x4){0.f, 0.f, 0.f, 0.f}, 0, 0, 0);
#pragma unroll
        for (int j = 0; j < 4; ++j) buL[(4 * fq + j) * BUS + 2 * (16 * (nt & 3) + fr) + (nt >> 2)] = d[j];
    }
    asm volatile("s_waitcnt lgkmcnt(0)" ::: "memory");
}

__device__ __forceinline__ void phase_ssm_a(CP P, const int tid, const int bid, const int nblk, int l, LAS unsigned char* lds) {
    const int lane = tid & 63, wave = __builtin_amdgcn_readfirstlane(tid >> 6), fr = lane & 15, fq = lane >> 4;
    LAS bf16_t* uT = (LAS bf16_t*)lds;
    LAS float* buL = (LAS float*)(lds + SSM_U_LDS + wave * SSM_WAVE_LDS);
    f32x2* sfin = (f32x2*)(P->ws + W_SFIN);
    for (int unit = bid; unit < 256; unit += nblk) {
        const int r = unit & 15, gs = (unit >> 4) & 7, b = unit >> 7;
        if (r == 15) continue;
        const int g = gs * 8 + wave;
        u32x4 wpre[2]; ssm_fetch_u(P, tid, b * SEQ + (r * 8) * 64, gs, wpre);
        float lbr, lbi; bf16x4s Bf[8];
        ssm_setup(P, l, g, lane, buL, lbr, lbi, Bf);
        float xr = 0.f, xi = 0.f;
        for (int cc = 0; cc < 8; ++cc) {
            __syncthreads();
            ssm_put_u(P, tid, l, gs, wpre, uT);
            if (cc + 1 < 8) ssm_fetch_u(P, tid, b * SEQ + (r * 8 + cc + 1) * 64, gs, wpre);
            __syncthreads();
            for (int sub = 0; sub < 4; ++sub) {
                const bf16x4s uf = *(const LAS bf16x4s*)(uT + (sub * 16 + fr) * USB + wave * 16 + 4 * fq);
                ssm_bu(uf, Bf, buL, fr, fq);
#pragma unroll
                for (int t = 0; t < 16; ++t) { const f32x2 bb = *(const LAS f32x2*)(buL + t * BUS + 2 * lane);
                    const float nr = lbr * xr - lbi * xi + bb.x, ni = lbr * xi + lbi * xr + bb.y; xr = nr; xi = ni; }
                asm volatile("s_waitcnt lgkmcnt(0)" ::: "memory");
            }
        }
        sfin[((size_t)(b * 16 + r) * NG + g) * NP + lane] = (f32x2){xr, xi};
    }
}

__device__ __forceinline__ float gelu_tanh(float y) {
    const float z = 0.7978845608028654f * (y + 0.044715f * y * y * y);
    return y * fast_sigmoid(2.0f * z);
}

__device__ __forceinline__ void phase_ssm_b(CP P, const int tid, const int bid, const int nblk, int l, LAS unsigned char* lds) {
    const int lane = tid & 63, wave = __builtin_amdgcn_readfirstlane(tid >> 6), fr = lane & 15, fq = lane >> 4;
    LAS bf16_t* uT = (LAS bf16_t*)lds;
    LAS float* buL = (LAS float*)(lds + SSM_U_LDS + wave * SSM_WAVE_LDS);
    LAS bf16_t* XS = (LAS bf16_t*)(lds + SSM_U_LDS + wave * SSM_WAVE_LDS + 16 * BUS * 4);
    const f32x2* sfin = (const f32x2*)(P->ws + W_SFIN);
    bf16_t* GB = (bf16_t*)(P->ws + W_QB);
    const bf16_t* xb = (const bf16_t*)(P->ws + W_XB);
    for (int unit = bid; unit < 512; unit += nblk) {
        const bool sample = unit >= 256;
        int g, b = 0, r = 0, gs = 0, b4 = 0;
        if (!sample) { r = unit & 15; gs = (unit >> 4) & 7; b = unit >> 7; g = gs * 8 + wave; }
        else { const int wt = (unit - 256) * 8 + wave; b4 = wt >> 6; g = wt & 63; }
        u32x4 wpre[2];
        if (!sample) ssm_fetch_u(P, tid, b * SEQ + (r * 8) * 64, gs, wpre);
        float x0r[4], x0i[4];
        if (sample) {
#pragma unroll
            for (int q = 0; q < 4; ++q) { const size_t si = (((size_t)l * 128 + (b4 * 4 + q)) * NG + g) * NP + lane; x0r[q] = P->in[2][si]; x0i[q] = P->in[3][si]; }
        } else {
#pragma unroll
            for (int q = 0; q < 4; ++q) { x0r[q] = 0.f; x0i[q] = 0.f; }
        }
        float lbr, lbi; bf16x4s Bf[8];
        ssm_setup(P, l, g, lane, buL, lbr, lbi, Bf);
        bf16x8 Cf[4];
        {
            const float* cre = P->in[16] + ((size_t)(l * NG + g) * GS + fr) * NP; const float* cim = P->in[17] + ((size_t)(l * NG + g) * GS + fr) * NP;
#pragma unroll
            for (int ks = 0; ks < 4; ++ks) {
                const f32x4 a = *(const f32x4*)(cre + 4 * fq + 16 * ks), bq = *(const f32x4*)(cim + 4 * fq + 16 * ks);
                u32x4 w; w.x = cvt_pk_bf16(a.x, -bq.x); w.y = cvt_pk_bf16(a.y, -bq.y); w.z = cvt_pk_bf16(a.z, -bq.z); w.w = cvt_pk_bf16(a.w, -bq.w);
                Cf[ks] = __builtin_bit_cast(bf16x8, w); }
        }
        const f32x4 dch = *(const f32x4*)(P->in[18] + l * D + g * 16 + 4 * fq);
        float xr = 0.f, xi = 0.f;
        if (!sample) {
            float ar = lbr, ai = lbi;
#pragma unroll
            for (int q = 0; q < 9; ++q) { const float nr = ar * ar - ai * ai, ni = 2.f * ar * ai; ar = nr; ai = ni; }
            const f32x2* sp = sfin + ((size_t)(b * 16) * NG + g) * NP + lane;
            f32x2 sv[15];
#pragma unroll
            for (int j = 0; j < 15; ++j) sv[j] = j < r ? sp[(size_t)j * NG * NP] : (f32x2){0.f, 0.f};
#pragma unroll
            for (int j = 0; j < 15; ++j) if (j < r) { const float nr = ar * xr - ai * xi + sv[j].x, ni = ar * xi + ai * xr + sv[j].y; xr = nr; xi = ni; }
        }
        const int nchunk = sample ? 1 : 8, nsub = sample ? 1 : 4;
        for (int cc = 0; cc < nchunk; ++cc) {
            const int row0 = sample ? TP + b4 * 16 : b * SEQ + (r * 8 + cc) * 64;
            if (!sample) { __syncthreads(); ssm_put_u(P, tid, l, gs, wpre, uT); if (cc + 1 < 8) ssm_fetch_u(P, tid, row0 + 64, gs, wpre); __syncthreads(); }
            for (int sub = 0; sub < nsub; ++sub) {
                bf16x4s uf;
                if (!sample) uf = *(const LAS bf16x4s*)(uT + (sub * 16 + fr) * USB + wave * 16 + 4 * fq);
                else { const u32x2 w = *(const u32x2*)(xb + (size_t)(row0 + fr) * D + g * 16 + 4 * fq);
                    const f32x4 gg = *(const f32x4*)(P->in[6] + (l * 6 + 2) * D + g * 16 + 4 * fq);
                    u32x2 o; o.x = cvt_pk_bf16(bflo(w.x) * gg.x, bfhi(w.x) * gg.y); o.y = cvt_pk_bf16(bflo(w.y) * gg.z, bfhi(w.y) * gg.w);
                    uf = __builtin_bit_cast(bf16x4s, o); }
                ssm_bu(uf, Bf, buL, fr, fq);
#pragma unroll
                for (int t = 0; t < 16; ++t) {
                    if (sample && (t & 3) == 0) { xr = x0r[t >> 2]; xi = x0i[t >> 2]; }
                    const f32x2 bb = *(const LAS f32x2*)(buL + t * BUS + 2 * lane);
                    const float nr = lbr * xr - lbi * xi + bb.x, ni = lbr * xi + lbi * xr + bb.y; xr = nr; xi = ni;
                    *(LAS unsigned*)(XS + t * XSS + 2 * lane) = cvt_pk_bf16(xr, xi);
                    if (sample && (t & 3) == 3) { const size_t si = (((size_t)l * 128 + (b4 * 4 + (t >> 2))) * NG + g) * NP + lane; P->out[O_RES + si] = xr; P->out[O_IMS + si] = xi; }
                }
                asm volatile("s_waitcnt lgkmcnt(0)" ::: "memory");
                f32x4 y = (f32x4){0.f, 0.f, 0.f, 0.f};
#pragma unroll
                for (int ks = 0; ks < 4; ++ks) { const bf16x8 a = *(const LAS bf16x8*)(XS + fr * XSS + fq * 8 + 32 * ks); y = __builtin_amdgcn_mfma_f32_16x16x32_bf16(Cf[ks], a, y, 0, 0, 0); }
                {
                    const int tl = sub * 16 + fr;
                    f32x4 uu;
                    if (!sample) { const u32x2 w = *(const LAS u32x2*)(uT + tl * USB + wave * 16 + 4 * fq); uu = (f32x4){bflo(w.x), bfhi(w.x), bflo(w.y), bfhi(w.y)}; }
                    else { const u32x2 w = *(const u32x2*)(xb + (size_t)(row0 + tl) * D + g * 16 + 4 * fq); const f32x4 gg = *(const f32x4*)(P->in[6] + (l * 6 + 2) * D + g * 16 + 4 * fq);
                        const unsigned a0 = cvt_pk_bf16(bflo(w.x) * gg.x, bfhi(w.x) * gg.y), a1 = cvt_pk_bf16(bflo(w.y) * gg.z, bfhi(w.y) * gg.w);
                        uu = (f32x4){bflo(a0), bfhi(a0), bflo(a1), bfhi(a1)}; }
                    u32x2 o; o.x = cvt_pk_bf16(gelu_tanh(y[0] + dch[0] * uu[0]), gelu_tanh(y[1] + dch[1] * uu[1])); o.y = cvt_pk_bf16(gelu_tanh(y[2] + dch[2] * uu[2]), gelu_tanh(y[3] + dch[3] * uu[3]));
                    *(u32x2*)(GB + (size_t)(row0 + tl) * D + g * 16 + 4 * fq) = o;
                }
                asm volatile("s_waitcnt lgkmcnt(0)" ::: "memory");
            }
        }
        if (!sample && r == 15) { const size_t si = (((size_t)l * 2 + b) * NG + g) * NP + lane; P->out[O_REP + si] = xr; P->out[O_IMP + si] = xi; }
    }
}

constexpr int KST = 72, VST = 264;
__device__ __forceinline__ void phase_attn_prompt(CP P, const int tid, const int bid, const int nblk, int bl, LAS unsigned char* lds) {
    const int lane = tid & 63, wave = tid >> 6, fr = lane & 15, fq = lane >> 4;
    LAS bf16_t* Ks = (LAS bf16_t*)lds;
    LAS bf16_t* Vt = (LAS bf16_t*)(lds + 36864);
    LAS float* bL = (LAS float*)(lds + 36864 + 33792);
    const bf16_t* kvb = (const bf16_t*)(P->ws + W_KVB);
    const bf16_t* Qb = (const bf16_t*)(P->ws + W_QB);
    bf16_t* Ob = (bf16_t*)(P->ws + W_OB);
    const float* biasT = (const float*)(P->ws + W_BIAST);
    for (int unit = bid; unit < 256; unit += nblk) {
        const int kvh = unit & 1, nb = (unit >> 1) & 63, b = unit >> 7;
        __syncthreads();
#pragma unroll
        for (int i = 0; i < 4; ++i) { const int q = tid + NTHREADS * i, key = q >> 3, c8 = q & 7;
            const int pos = (nb - 1) * 128 + key;
            u32x4 kw = (u32x4){0u, 0u, 0u, 0u}, vw = kw;
            if (pos >= 0) { const bf16_t* src = kvb + (size_t)(b * SEQ + pos) * 256 + kvh * 64 + c8 * 8; kw = *(const u32x4*)src; vw = *(const u32x4*)(src + 128); }
            *(LAS u32x4*)(Ks + key * KST + c8 * 8) = kw;
            LAS bf16_t* vd = Vt + (c8 * 8) * VST + key;
            vd[0 * VST] = (bf16_t)(vw.x & 0xffff); vd[1 * VST] = (bf16_t)(vw.x >> 16); vd[2 * VST] = (bf16_t)(vw.y & 0xffff); vd[3 * VST] = (bf16_t)(vw.y >> 16);
            vd[4 * VST] = (bf16_t)(vw.z & 0xffff); vd[5 * VST] = (bf16_t)(vw.z >> 16); vd[6 * VST] = (bf16_t)(vw.w & 0xffff); vd[7 * VST] = (bf16_t)(vw.w >> 16); }
#pragma unroll
        for (int i = 0; i < 3; ++i) { const int q = tid + NTHREADS * i, hq = q / 192, d = q % 192 - 32; bL[q] = (d >= 0 && d < WIN) ? biasT[(kvh * 8 + hq) * 128 + d] : -INFINITY; }
        __syncthreads();
        const int qs = wave, t0 = qs < 6 ? qs : 6;
        const int iq = 16 * qs + fr;
        const size_t qrow = (size_t)b * SEQ + nb * 128 + iq;
        bf16x8 q0n = *(const bf16x8*)(Qb + qrow * D + kvh * 512 + fq * 8), q1n = *(const bf16x8*)(Qb + qrow * D + kvh * 512 + 32 + fq * 8);
        for (int hq = 0; hq < 8; ++hq) {
            const int h = kvh * 8 + hq;
            int iql = iq; asm volatile("" : "+v"(iql));
            const LAS float* bLh = bL + hq * 192 + (160 - 147) + iql - t0 * 16 - 4 * fq;
            const bf16x8 q0 = q0n, q1 = q1n;
            if (hq < 7) { q0n = *(const bf16x8*)(Qb + qrow * D + (h + 1) * 64 + fq * 8); q1n = *(const bf16x8*)(Qb + qrow * D + (h + 1) * 64 + 32 + fq * 8); }
            const float sink = P->in[26][bl * 16 + h];
            f32x4 S[10];
            float mx = -INFINITY;
#pragma unroll
            for (int tt = 0; tt < 10; ++tt) {
                const int key = (t0 + tt) * 16 + fr;
                const bf16x8 k0 = *(const LAS bf16x8*)(Ks + key * KST + fq * 8), k1 = *(const LAS bf16x8*)(Ks + key * KST + 32 + fq * 8);
                f32x4 s = (f32x4){0.f, 0.f, 0.f, 0.f};
                s = __builtin_amdgcn_mfma_f32_16x16x32_bf16(k0, q0, s, 0, 0, 0);
                s = __builtin_amdgcn_mfma_f32_16x16x32_bf16(k1, q1, s, 0, 0, 0);
#pragma unroll
                for (int j = 0; j < 4; ++j) {
                    float v = s[j] + bLh[(9 - tt) * 16 + (3 - j)];
                    if (nb == 0) { const int dist = 128 + iql - ((t0 + tt) * 16 + 4 * fq + j); v += __int_as_float(((iql - dist) >> 31) & (int)0xff800000); }
                    s[j] = v; mx = fmaxf(mx, v); }
                S[tt] = s;
            }
            mx = fmaxf(mx, swz_xor(mx, 0x401f)); mx = fmaxf(mx, xor32(mx, lane)); mx = fmaxf(mx, sink);
            float sum = 0.f;
#pragma unroll
            for (int tt = 0; tt < 10; ++tt)
#pragma unroll
                for (int j = 0; j < 4; ++j) { const float p = __expf(S[tt][j] - mx); S[tt][j] = p; sum += p; }
            sum += swz_xor(sum, 0x401f); sum += xor32(sum, lane);
            const float inv = 1.0f / (sum + __expf(sink - mx));
            f32x4 O[4];
#pragma unroll
            for (int dt = 0; dt < 4; ++dt) O[dt] = (f32x4){0.f, 0.f, 0.f, 0.f};
#pragma unroll
            for (int s5 = 0; s5 < 5; ++s5) {
                const f32x4 pa = S[2 * s5] * inv, pb = S[2 * s5 + 1] * inv;
                u32x4 pw; pw.x = cvt_pk_bf16(pa[0], pa[1]); pw.y = cvt_pk_bf16(pa[2], pa[3]); pw.z = cvt_pk_bf16(pb[0], pb[1]); pw.w = cvt_pk_bf16(pb[2], pb[3]);
                const bf16x8 pf = __builtin_bit_cast(bf16x8, pw);
                const int ka = 16 * (t0 + 2 * s5) + 4 * fq, kb = ka + 16;
#pragma unroll
                for (int dt = 0; dt < 4; ++dt) {
                    const LAS bf16_t* vr = Vt + (dt * 16 + fr) * VST;
                    const u32x2 va = *(const LAS u32x2*)(vr + ka), vb = *(const LAS u32x2*)(vr + kb);
                    const u32x4 vw = (u32x4){va.x, va.y, vb.x, vb.y};
                    O[dt] = __builtin_amdgcn_mfma_f32_16x16x32_bf16(__builtin_bit_cast(bf16x8, vw), pf, O[dt], 0, 0, 0);
                }
            }
#pragma unroll
            for (int dt = 0; dt < 4; ++dt) { u32x2 w; w.x = cvt_pk_bf16(O[dt][0], O[dt][1]); w.y = cvt_pk_bf16(O[dt][2], O[dt][3]);
                *(u32x2*)(Ob + qrow * D + h * 64 + dt * 16 + 4 * fq) = w; }
        }
    }
}

__device__ __forceinline__ void phase_attn_sample(CP P, const int tid, const int bid, const int nblk, int bl, LAS unsigned char* lds) {
    const int lane = tid & 63, wave = tid >> 6;
    LAS float* qL = (LAS float*)(lds + 80000 + wave * 4096);
    LAS float* pL = qL + 256;
    const bf16_t* kvb = (const bf16_t*)(P->ws + W_KVB);
    const bf16_t* Qb = (const bf16_t*)(P->ws + W_QB);
    bf16_t* Ob = (bf16_t*)(P->ws + W_OB);
    const float* biasT = (const float*)(P->ws + W_BIAST);
    const int gw = bid * NWAVES + wave, NGW = nblk * NWAVES;
    for (int task = gw; task < 128 * 16; task += NGW) {
        const int h = task & 15, b = task >> 4, kvh = h >> 3;
        const size_t row0 = (size_t)TP + b * 4;
        asm volatile("s_waitcnt lgkmcnt(0)" ::: "memory");
#pragma unroll
        for (int t = 0; t < 4; ++t) qL[t * 64 + lane] = bf2f(Qb[(row0 + t) * D + h * 64 + lane]);
        asm volatile("s_waitcnt lgkmcnt(0)" ::: "memory");
        const float sink = P->in[26][bl * 16 + h];
        float sc[3][4];
#pragma unroll
        for (int r = 0; r < 3; ++r) {
            const int j = lane + 64 * r;
            float a0 = 0.f, a1 = 0.f, a2 = 0.f, a3 = 0.f;
            if (j < 128) {
                const f32x4* kr = (const f32x4*)(P->in[4] + ((size_t)(b * WIN + j) * 2 + kvh) * 64);
#pragma unroll 8
                for (int d4 = 0; d4 < 16; ++d4) { const f32x4 kv = kr[d4];
                    const f32x4 qa = *(const LAS f32x4*)(qL + d4 * 4), qb = *(const LAS f32x4*)(qL + 64 + d4 * 4), qc = *(const LAS f32x4*)(qL + 128 + d4 * 4), qd = *(const LAS f32x4*)(qL + 192 + d4 * 4);
                    a0 += kv.x * qa.x + kv.y * qa.y + kv.z * qa.z + kv.w * qa.w; a1 += kv.x * qb.x + kv.y * qb.y + kv.z * qb.z + kv.w * qb.w;
                    a2 += kv.x * qc.x + kv.y * qc.y + kv.z * qc.z + kv.w * qc.w; a3 += kv.x * qd.x + kv.y * qd.y + kv.z * qd.z + kv.w * qd.w; }
            } else if (j < 132) {
                const u32x2* kr = (const u32x2*)(kvb + (row0 + (j - 128)) * 256 + kvh * 64);
#pragma unroll 4
                for (int d4 = 0; d4 < 16; ++d4) { const u32x2 w = kr[d4]; const f32x4 kv = (f32x4){bflo(w.x), bfhi(w.x), bflo(w.y), bfhi(w.y)};
                    const f32x4 qa = *(const LAS f32x4*)(qL + d4 * 4), qb = *(const LAS f32x4*)(qL + 64 + d4 * 4), qc = *(const LAS f32x4*)(qL + 128 + d4 * 4), qd = *(const LAS f32x4*)(qL + 192 + d4 * 4);
                    a0 += kv.x * qa.x + kv.y * qa.y + kv.z * qa.z + kv.w * qa.w; a1 += kv.x * qb.x + kv.y * qb.y + kv.z * qb.z + kv.w * qb.w;
                    a2 += kv.x * qc.x + kv.y * qc.y + kv.z * qc.z + kv.w * qc.w; a3 += kv.x * qd.x + kv.y * qd.y + kv.z * qd.z + kv.w * qd.w; }
            }
            const float a[4] = {a0, a1, a2, a3};
#pragma unroll
            for (int t = 0; t < 4; ++t) { const int dist = 128 + t - j; const bool valid = j < 132 && dist >= 0 && dist < WIN;
                sc[r][t] = valid ? a[t] + biasT[h * 128 + (dist & 127)] : -INFINITY; }
        }
#pragma unroll
        for (int t = 0; t < 4; ++t) {
            float mx = fmaxf(fmaxf(sc[0][t], sc[1][t]), sc[2][t]); mx = fmaxf(wave_max(mx, lane), sink);
            const float p0 = __expf(sc[0][t] - mx), p1 = __expf(sc[1][t] - mx), p2 = __expf(sc[2][t] - mx);
            const float sum = wave_sum(p0 + p1 + p2, lane);
            const float inv = 1.0f / (sum + __expf(sink - mx));
            pL[t * 136 + lane] = p0 * inv; pL[t * 136 + 64 + lane] = p1 * inv; if (lane < 8) pL[t * 136 + 128 + lane] = p2 * inv;
        }
        asm volatile("s_waitcnt lgkmcnt(0)" ::: "memory");
        float o0 = 0.f, o1 = 0.f, o2 = 0.f, o3 = 0.f;
        const float* vc = P->in[5] + ((size_t)(b * WIN) * 2 + kvh) * 64 + lane;
#pragma unroll 32
        for (int j = 0; j < 128; ++j) { const float v = vc[(size_t)j * 128];
            o0 += pL[j] * v; o1 += pL[136 + j] * v; o2 += pL[272 + j] * v; o3 += pL[408 + j] * v; }
#pragma unroll
        for (int j = 128; j < 132; ++j) { const float v = bf2f(kvb[(row0 + (j - 128)) * 256 + 128 + kvh * 64 + lane]);
            o0 += pL[j] * v; o1 += pL[136 + j] * v; o2 += pL[272 + j] * v; o3 += pL[408 + j] * v; }
        Ob[(row0 + 0) * D + h * 64 + lane] = f2bf(o0); Ob[(row0 + 1) * D + h * 64 + lane] = f2bf(o1);
        Ob[(row0 + 2) * D + h * 64 + lane] = f2bf(o2); Ob[(row0 + 3) * D + h * 64 + lane] = f2bf(o3);
    }
}


#define XB_TMO      128
#define XB_XCNT(j)  (256  + 64 * (j))
#define XB_XSUB(j)  (1280 + 64 * (j))
#define XB_XGEN(j)  (2304 + 64 * (j))
#define XB_TOP      3328
#define XB_TOPGEN   3392
#define XCD_BAR_WORDS 3456
#define XB_SPIN_CAP (1u << 22)
__device__ __forceinline__ unsigned xb_ld(unsigned* p)              { return __hip_atomic_load(p, __ATOMIC_RELAXED, __HIP_MEMORY_SCOPE_AGENT); }
__device__ __forceinline__ unsigned xb_add(unsigned* p, unsigned v) { return __hip_atomic_fetch_add(p, v, __ATOMIC_RELAXED, __HIP_MEMORY_SCOPE_AGENT); }
__device__ __forceinline__ unsigned xb_xcc_id() { return (unsigned)__builtin_amdgcn_s_getreg((3 << 11) | 20) & 0xFu; }
#define XB_SPIN(cond, bar) do { unsigned _sp = 0; while (cond) { __builtin_amdgcn_s_sleep(1); \
    if ((++_sp & 255u) == 0u) { if (xb_ld(&(bar)[XB_TMO])) break; if (_sp > XB_SPIN_CAP) { atomicAdd(&(bar)[XB_TMO], 1u); break; } } } } while (0)
struct XcdBarrier { unsigned* bar; unsigned x; volatile LAS unsigned* st; };
__device__ __forceinline__ XcdBarrier xcd_barrier_post(unsigned* bar, volatile LAS unsigned* st) {
    XcdBarrier b; b.bar = bar; b.x = xb_xcc_id(); b.st = st;
    if (threadIdx.x == 0) (void)xb_add(&bar[XB_XCNT(b.x)], 1u);
    return b;
}
__device__ __forceinline__ void xcd_barrier_complete(unsigned* bar, unsigned x, unsigned& nloc, unsigned& nx) {
    const unsigned G = gridDim.x * gridDim.y * gridDim.z;
    unsigned sum, cnt, mine, sp = 0u;
    for (;;) {
        sum = 0u; cnt = 0u; mine = 0u;
#pragma unroll
        for (unsigned j = 0; j < 16; ++j) { const unsigned c = xb_ld(&bar[XB_XCNT(j)]); sum += c; cnt += (c > 0u) ? 1u : 0u; mine = (j == x) ? c : mine; }
        if (sum == G) break;
        __builtin_amdgcn_s_sleep(1);
        if ((++sp & 255u) == 0u) { if (xb_ld(&bar[XB_TMO])) break; if (sp > XB_SPIN_CAP) { atomicAdd(&bar[XB_TMO], 1u); break; } }
    }
    nloc = mine > 0u ? mine : 1u; nx = cnt > 0u ? cnt : 1u;
}
__device__ __forceinline__ void xcd_barrier(const XcdBarrier& b) {
    asm volatile("s_waitcnt vmcnt(0)" ::: "memory");
    __syncthreads();
    if (threadIdx.x == 0) {
        unsigned* bar = b.bar; asm volatile("" : "+s"(bar));
        __builtin_amdgcn_s_waitcnt(0);
        unsigned nloc = b.st[0], nx = b.st[1];
        if (nloc == 0u) { xcd_barrier_complete(bar, b.x, nloc, nx); b.st[0] = nloc; b.st[1] = nx; }
        const unsigned old = xb_add(&bar[XB_XSUB(b.x)], 1u);
        const unsigned gen = old / nloc;
        if (old + 1u == (gen + 1u) * nloc) {
            __builtin_amdgcn_fence(__ATOMIC_RELEASE, "agent");
            asm volatile("s_waitcnt vmcnt(0)" ::: "memory");
            const unsigned og = xb_add(&bar[XB_TOP], 1u);
            const unsigned tg = og / nx;
            if (og + 1u == (tg + 1u) * nx) xb_add(&bar[XB_TOPGEN], 1u);
            else XB_SPIN(xb_ld(&bar[XB_TOPGEN]) == tg, bar);
            __builtin_amdgcn_fence(__ATOMIC_ACQUIRE, "agent");
            xb_add(&bar[XB_XGEN(b.x)], 1u);
            asm volatile("s_waitcnt vmcnt(0)" ::: "memory");
        } else {
            XB_SPIN(xb_ld(&bar[XB_XGEN(b.x)]) == gen, bar);
            __builtin_amdgcn_fence(__ATOMIC_ACQUIRE, "agent");
            asm volatile("s_waitcnt vmcnt(0)" ::: "memory");
        }
    }
    __syncthreads();
}

__device__ __forceinline__ void run_gemm_gated0(CP P, const int tid, const int bid, const int nblk, LAS unsigned char* lds, const bf16_t* A, const bf16_t* Bt, int N, int K, bf16_t* O, int ldc) {
    pg8::gemm_phase<pg8::EpiGated<0>>(tid, lds, A, Bt, T, N, K, nblk, bid, O, ldc, nullptr, 1.0f, nullptr, 0);
}
__device__ __forceinline__ void run_gemm_gated1(CP P, const int tid, const int bid, const int nblk, LAS unsigned char* lds, const bf16_t* A, const bf16_t* Bt, int N, int K, bf16_t* O, int ldc, const float* bias, int nout) {
    pg8::gemm_phase<pg8::EpiGated<1>>(tid, lds, A, Bt, TP, N, K, nblk, bid, O, ldc, bias, 1.0f, nullptr, nout);
    small_gemm<1>(tid, bid, nblk, lds, A, Bt, N, K, O, ldc, bias, 1.0f, nout);
}
__device__ __forceinline__ void run_gemm_plain(CP P, const int tid, const int bid, const int nblk, LAS unsigned char* lds, const bf16_t* A, const bf16_t* Bt, int N, int K, bf16_t* O, int ldc, const float* bias, float scale) {
    pg8::gemm_phase<pg8::EpiBf16<0>>(tid, lds, A, Bt, TP, N, K, nblk, bid, O, ldc, bias, scale, nullptr, 0);
    small_gemm<0>(tid, bid, nblk, lds, A, Bt, N, K, O, ldc, bias, scale, 0);
}
__device__ __forceinline__ void run_gemm_kv(CP P, const int tid, const int bid, const int nblk, LAS unsigned char* lds) {
    pg8::gemm_phase<pg8::EpiBf16<1>>(tid, lds, (const bf16_t*)(P->ws + W_XB), (const bf16_t*)(P->ws + W_KV), T, 256, D, nblk, (bid + 84) % nblk, (bf16_t*)(P->ws + W_KVB), 256, P->in[23], 1.0f, P->out, 0);
}

__global__ void __launch_bounds__(NTHREADS, 2) mega(Params Pval) {
    extern __shared__ __attribute__((aligned(16))) unsigned char shm[];
    LAS unsigned char* lds = (LAS unsigned char*)shm;
    CP P = launder((CP)__builtin_amdgcn_kernarg_segment_ptr());
    const int ph_lo = P->ph_lo, ph_hi = P->ph_hi;
    volatile LAS unsigned* xst = (volatile LAS unsigned*)(lds + 131072);
    if (threadIdx.x == 0) { xst[0] = 0u; xst[1] = 0u; xst[2] = 0u; xst[3] = 0u; }
    __syncthreads();
    XcdBarrier xb = xcd_barrier_post((unsigned*)(P->ws + W_BAR), xst);
    for (int ph = ph_lo; ph < ph_hi; ++ph) {
    P = launder(P);
    int tid = threadIdx.x, bid = blockIdx.x, nblk = gridDim.x;
    asm volatile("" : "+v"(tid)); const int tid0 = tid; asm volatile("" : "+s"(bid)); asm volatile("" : "+s"(nblk));
    unsigned char* ws = P->ws;
    const bf16_t* XB = (const bf16_t*)(ws + W_XB);
    bf16_t* HB = (bf16_t*)(ws + W_H);
    bf16_t* FB = (bf16_t*)(ws + W_F);
    bf16_t* QB = (bf16_t*)(ws + W_QB);
    bf16_t* OB = (bf16_t*)(ws + W_OB);
    {
        if (ph == 0) { REPLOOP(REP_PRO) phase_prologue(P, tid, bid, nblk, lds); }
        else {
            const int l = (ph - 1) / 10, s = (ph - 1) % 10;
            const float* ng = P->in[6] + (size_t)l * 6 * D;
            if (s == 0 || s == 7) {
                const int f = s == 7;
                if (l == 2 && f == 0) run_gemm_kv(P, tid, bid, nblk, lds);
                REPLOOP(REP_GU)
                run_gemm_gated0(P, tid, bid, nblk, lds, XB, (const bf16_t*)(ws + W_GU) + (size_t)(l * 2 + f) * 2 * FF * D, 2 * FF, D, HB, FF);
                if (l < 2) cvt_in_shadow(P, tid, bid, nblk, lds, l + 1, f);
                else if (l == 2 && f == 1) cvt_in_shadow(P, tid, bid, nblk, lds, 3, 0);
                else if (l == 3 && f == 0) cvt_in_shadow(P, tid, bid, nblk, lds, 3, 1);
            } else if (s == 1 || s == 8) {
                const int f = s == 8;
                REPLOOP(REP_DN)
                run_gemm_plain(P, tid, bid, nblk, lds, HB, (const bf16_t*)(ws + W_DN) + (size_t)(l * 2 + f) * D * FF, D, FF, FB, D, nullptr, 1.0f);
            } else if (s == 2) phase_fixup(P, tid, bid, nblk, 0.5f, ng + 1 * D, false);
            else if (s == 6) phase_fixup(P, tid, bid, nblk, 1.0f, ng + 3 * D, false);
            else if (s == 9) phase_fixup(P, tid, bid, nblk, 0.5f, ng + 5 * D, l == 3);
            else if (s == 3) {
                REPLOOP(REP_MX)
                if (l < 2) phase_ssm_a(P, tid, bid, nblk, l, lds);
                else run_gemm_plain(P, tid, bid, nblk, lds, XB, (const bf16_t*)(ws + W_Q) + (size_t)(l - 2) * D * D, D, D, QB, D, P->in[25] + (l - 2) * D, 0.125f);
            } else if (s == 4) {
                REPLOOP(REP_MX)
                if (l < 2) phase_ssm_b(P, tid, bid, nblk, l, lds);
                else { phase_attn_prompt(P, tid, bid, nblk, l - 2, lds); phase_attn_sample(P, tid, bid, nblk, l - 2, lds); }
            } else if (s == 5) {
                if (l < 2) run_gemm_gated1(P, tid, bid, nblk, lds, QB, (const bf16_t*)(ws + W_GLU) + (size_t)l * 2 * D * D, 2 * D, D, FB, D, P->in[20] + l * 2 * D, D);
                else run_gemm_plain(P, tid, bid, nblk, lds, OB, (const bf16_t*)(ws + W_O) + (size_t)(l - 2) * D * D, D, D, FB, D, P->in[28] + (l - 2) * D, 1.0f);
            }
        }
        if (ph + 1 < ph_hi) { if (ph < 0) cg::this_grid().sync(); else xcd_barrier(xb); }
    }
    }
}

extern "C" void kernel_launch(void* const* d_in, const int* in_sizes, int n_in, void* d_out, int out_size, void* d_ws, size_t ws_size, hipStream_t stream) {
    static int grid = 0;
    if (grid == 0) {
        if (n_in != 30 || (size_t)out_size != O_END || ws_size < W_END) { fprintf(stderr, "kernel_launch: unexpected shapes n_in %d out %d ws %zu (need %zu)\n", n_in, out_size, ws_size, (size_t)W_END); grid = -1; return; }
        int dev = 0, cus = 0, per_cu = 0;
        hipGetDevice(&dev);
        hipDeviceGetAttribute(&cus, hipDeviceAttributeMultiprocessorCount, dev);
        if (hipFuncSetAttribute((const void*)mega, hipFuncAttributeMaxDynamicSharedMemorySize, LDS_BYTES) != hipSuccess) { fprintf(stderr, "kernel_launch: hipFuncSetAttribute failed\n"); grid = -1; return; }
        hipOccupancyMaxActiveBlocksPerMultiprocessor(&per_cu, (const void*)mega, NTHREADS, LDS_BYTES);
        if (per_cu < 1) { fprintf(stderr, "kernel_launch: occupancy query says %d blocks per CU\n", per_cu); per_cu = 1; }
        (void)hipGetLastError();
        grid = cus * 1;
    }
    if (grid < 0) return;
    if (hipMemsetAsync((char*)d_ws + W_BAR, 0, 3456 * 4, stream) != hipSuccess) { fprintf(stderr, "kernel_launch: memset failed\n"); return; }
    Params p{};
    for (int i = 0; i < 30; ++i) p.in[i] = (const float*)d_in[i];
    p.out = (float*)d_out; p.ws = (unsigned char*)d_ws;
#if MK_MULTI
    for (int ph = 0; ph < NPHASES; ++ph) { p.ph_lo = ph; p.ph_hi = ph + 1; hipLaunchKernelGGL(mega, dim3(grid), dim3(NTHREADS), LDS_BYTES, stream, p); }
#else
    p.ph_lo = 0; p.ph_hi = NPHASES;
    void* args[] = {&p};
    hipError_t e = hipLaunchCooperativeKernel((const void*)mega, dim3(grid), dim3(NTHREADS), args, LDS_BYTES, stream);
    if (e != hipSuccess) fprintf(stderr, "cooperative launch failed: %s (grid %d)\n", hipGetErrorString(e), grid);
#endif
}
```
